# Optimizing an MI355X kernel written in HIP

```python
import math
import jax, jax.numpy as jnp
from jax import lax
import numpy as np

D_MODEL = 1024
BATCH = 4
SEQ = 8192
DEPTH = 1

M_WIDTH = D_MODEL // 2
M_HEADS = 4
M_HEAD_DIM = M_WIDTH // M_HEADS
CONV_K = 4
MLSTM_CHUNK = 128
G_WIDTH = D_MODEL // 2
G_GROUPS = 4
G_GROUP_DIM = G_WIDTH // G_GROUPS
SG_CHUNK = 128
D_MIX = M_WIDTH + G_WIDTH
IN_COLS = 2 * M_WIDTH + 2 * G_WIDTH
N_EXPERTS = 256
TOP_K = 8
N_GROUPS = 8
TOPK_GROUPS = 4
EXP_PER_GROUP = N_EXPERTS // N_GROUPS
D_EXPERT = D_MODEL // 4
ROUTE_SCALE = 2.5
DISPATCH_BLOCK = 128
DN_ALPHA = (2 * DEPTH) ** 0.25
DN_BETA = (8 * DEPTH) ** -0.25
LN_EPS = 1e-5

kernel_name = "hybrid_mlstm_sgmlp_moe_deepnorm"


def _layernorm(x):
    xf = x.astype(jnp.float32)
    mu = jnp.mean(xf, axis=-1, keepdims=True)
    var = jnp.mean(jnp.square(xf - mu), axis=-1, keepdims=True)
    return ((xf - mu) * lax.rsqrt(var + LN_EPS)).astype(x.dtype)


def _causal_dwconv(x, w, b):
    y = lax.conv_general_dilated(x, w[:, None, :], window_strides=(1,), padding=[(CONV_K - 1, 0)],
                                 dimension_numbers=('NWC', 'WIO', 'NWC'), feature_group_count=x.shape[-1])
    return y + b


def _mlstm_chunkwise(q, k, v, i_pre, f_pre):
    bsz, nh, seq, dh = q.shape
    L = MLSTM_CHUNK
    nc = seq // L
    q = q.reshape(bsz, nh, nc, L, dh)
    k = k.reshape(bsz, nh, nc, L, dh)
    v = v.reshape(bsz, nh, nc, L, dh)
    log_i = i_pre.reshape(bsz, nh, nc, L)
    b = jnp.cumsum(jax.nn.log_sigmoid(f_pre).reshape(bsz, nh, nc, L), axis=-1)
    g = b[..., -1]
    a = g[..., None] - b + log_i

    def step(carry, xs):
        c_st, n_st, m_st = carry
        g_j, a_j, k_j, v_j = xs
        m_new = jnp.maximum(g_j + m_st, jnp.max(a_j, axis=-1))
        decay = jnp.exp(g_j + m_st - m_new)
        w_j = jnp.exp(a_j - m_new[..., None])
        c_new = decay[..., None, None] * c_st + jnp.einsum('bhl,bhld,bhle->bhde', w_j, v_j, k_j)
        n_new = decay[..., None] * n_st + jnp.einsum('bhl,bhle->bhe', w_j, k_j)
        return (c_new, n_new, m_new), (c_st, n_st, m_st)

    init = (jnp.zeros((bsz, nh, dh, dh), jnp.float32), jnp.zeros((bsz, nh, dh), jnp.float32),
            jnp.zeros((bsz, nh), jnp.float32))
    front = lambda t: jnp.moveaxis(t, 2, 0)
    _, (c_prev, n_prev, m_prev) = lax.scan(step, init, (front(g), front(a), front(k), front(v)))
    c_prev = jnp.moveaxis(c_prev, 0, 2)
    n_prev = jnp.moveaxis(n_prev, 0, 2)
    m_prev = jnp.moveaxis(m_prev, 0, 2)

    causal = jnp.tril(jnp.ones((L, L), bool))
    log_d = jnp.where(causal, b[..., :, None] - b[..., None, :] + log_i[..., None, :], -jnp.inf)
    log_inter = b + m_prev[..., None]
    m_t = jnp.maximum(log_inter, jnp.max(log_d, axis=-1))
    p = jnp.exp(log_d - m_t[..., None]) * jnp.einsum('bhctd,bhcsd->bhcts', q, k)
    w_inter = jnp.exp(log_inter - m_t)
    num = w_inter[..., None] * jnp.einsum('bhcde,bhcte->bhctd', c_prev, q) + jnp.einsum('bhcts,bhcsd->bhctd', p, v)
    nq = w_inter * jnp.einsum('bhce,bhcte->bhct', n_prev, q) + jnp.sum(p, axis=-1)
    h = num / jnp.maximum(jnp.abs(nq), jnp.exp(-m_t))[..., None]
    return h.reshape(bsz, nh, seq, dh)


def _hybrid_mixer(h, w_in, conv_w, conv_b, w_q, w_k, w_v, w_if, b_if, mh_g, skip, sg_g, sg_b, w_sp, b_sp, w_out):
    bsz, seq, _ = h.shape
    proj = h @ w_in
    xm, z, u, v = jnp.split(proj, [M_WIDTH, 2 * M_WIDTH, 2 * M_WIDTH + G_WIDTH], axis=-1)
    xc = jax.nn.silu(_causal_dwconv(xm, conv_w, conv_b))
    heads = lambda t: t.reshape(bsz, seq, M_HEADS, M_HEAD_DIM)
    q = jnp.einsum('bshd,hde->bshe', heads(xc), w_q)
    k = jnp.einsum('bshd,hde->bshe', heads(xc), w_k) * (M_HEAD_DIM ** -0.5)
    vv = jnp.einsum('bshd,hde->bshe', heads(xm), w_v)
    flat = lambda t: t.reshape(bsz, seq, M_WIDTH)
    gate_pre = (jnp.concatenate([flat(q), flat(k), flat(vv)], axis=-1) @ w_if + b_if).astype(jnp.float32)
    i_pre = jnp.transpose(gate_pre[..., :M_HEADS], (0, 2, 1))
    f_pre = jnp.transpose(gate_pre[..., M_HEADS:], (0, 2, 1))
    to_bhsd = lambda t: jnp.transpose(t, (0, 2, 1, 3)).astype(jnp.float32)
    hc = _mlstm_chunkwise(to_bhsd(q), to_bhsd(k), to_bhsd(vv), i_pre, f_pre)
    hc = _layernorm(jnp.transpose(hc, (0, 2, 1, 3))) * mh_g.reshape(M_HEADS, M_HEAD_DIM)
    hm = jax.nn.sigmoid(z) * (hc.reshape(bsz, seq, M_WIDTH).astype(h.dtype) + skip * xc)
    nc = seq // SG_CHUNK
    ug = jax.nn.gelu(u, approximate=False).reshape(bsz, nc, SG_CHUNK, G_GROUPS, G_GROUP_DIM)
    vg = jax.nn.gelu(v, approximate=False).reshape(bsz, nc, SG_CHUNK, G_GROUPS, G_GROUP_DIM)
    vn = _layernorm(vg) * sg_g.reshape(G_GROUPS, G_GROUP_DIM) + sg_b.reshape(G_GROUPS, G_GROUP_DIM)
    ws = jnp.tril(w_sp)
    s = jnp.einsum('gts,bcsgd->bctgd', ws, vn) + b_sp.T[:, :, None]
    hg = (ug * s).reshape(bsz, seq, G_WIDTH)
    return jnp.concatenate([hm, hg], axis=-1) @ w_out


def _route(h_flat, w_router, e_bias):
    t = h_flat.shape[0]
    scores = jax.nn.sigmoid(h_flat.astype(jnp.float32) @ w_router.astype(jnp.float32))
    sel = scores + e_bias.astype(jnp.float32)
    grp_score = jnp.sum(lax.top_k(sel.reshape(t, N_GROUPS, EXP_PER_GROUP), 2)[0], axis=-1)
    _, grp_idx = lax.top_k(grp_score, TOPK_GROUPS)
    grp_mask = jnp.any(grp_idx[:, :, None] == jnp.arange(N_GROUPS)[None, None, :], axis=1)
    sel = jnp.where(jnp.repeat(grp_mask, EXP_PER_GROUP, axis=1), sel, -jnp.inf)
    _, idx = lax.top_k(sel, TOP_K)
    w = jnp.take_along_axis(scores, idx, axis=1)
    w = w / jnp.sum(w, axis=-1, keepdims=True) * ROUTE_SCALE
    return idx, w


def _routed_experts(h_flat, idx, wts, w_gate, w_up, w_down):
    t, d = h_flat.shape
    n_assign = t * TOP_K
    flat_e = idx.reshape(n_assign)
    flat_tok = jnp.arange(n_assign, dtype=jnp.int32) // TOP_K
    flat_w = wts.reshape(n_assign).astype(h_flat.dtype)
    order = jnp.argsort(flat_e, stable=True)
    e_sorted = flat_e[order]
    counts = jnp.bincount(flat_e, length=N_EXPERTS)
    padded = (counts + DISPATCH_BLOCK - 1) // DISPATCH_BLOCK * DISPATCH_BLOCK
    pad_end = jnp.cumsum(padded)
    pad_start = pad_end - padded
    start = jnp.cumsum(counts) - counts
    dest = pad_start[e_sorted] + jnp.arange(n_assign, dtype=jnp.int32) - start[e_sorted]
    n_blocks = (n_assign + N_EXPERTS * (DISPATCH_BLOCK - 1) + DISPATCH_BLOCK - 1) // DISPATCH_BLOCK
    n_slots = n_blocks * DISPATCH_BLOCK
    slot_tok = jnp.full((n_slots,), t, jnp.int32).at[dest].set(flat_tok[order])
    slot_w = jnp.zeros((n_slots,), h_flat.dtype).at[dest].set(flat_w[order])
    block_e = jnp.minimum(jnp.searchsorted(pad_end, jnp.arange(n_blocks) * DISPATCH_BLOCK, side='right'),
                          N_EXPERTS - 1)
    h_pad = jnp.concatenate([h_flat, jnp.zeros((1, d), h_flat.dtype)], axis=0)

    def body(acc, xs):
        tok, w, e = xs
        xb = h_pad[tok]
        y = (jax.nn.silu(xb @ w_gate[e]) * (xb @ w_up[e])) @ w_down[e]
        return acc.at[tok].add(y * w[:, None]), None

    acc, _ = lax.scan(body, jnp.zeros((t + 1, d), h_flat.dtype),
                      (slot_tok.reshape(n_blocks, DISPATCH_BLOCK), slot_w.reshape(n_blocks, DISPATCH_BLOCK), block_e))
    return acc[:t]


def _moe(h, w_router, e_bias, w_gate, w_up, w_down, ws_gate, ws_up, ws_down):
    bsz, seq, d = h.shape
    h_flat = h.reshape(bsz * seq, d)
    idx, wts = _route(h_flat, w_router, e_bias)
    routed = _routed_experts(h_flat, idx, wts, w_gate, w_up, w_down)
    shared = (jax.nn.silu(h_flat @ ws_gate) * (h_flat @ ws_up)) @ ws_down
    return (routed + shared).reshape(bsz, seq, d)


def setup_inputs(seed: int = 0) -> dict:
    key = jax.random.key(seed)
    ks = jax.random.split(key, 40)
    nrm = lambda k, shape, scale: jax.random.normal(k, shape, jnp.float32) * scale
    L = DEPTH
    b_i = nrm(ks[11], (L, M_HEADS), 0.1)
    b_f = jnp.linspace(3.0, 6.0, M_HEADS, dtype=jnp.float32)[None, :] + nrm(ks[12], (L, M_HEADS), 0.1)
    return {
        "x": nrm(ks[0], (BATCH, SEQ, D_MODEL), 1.0),
        "c": nrm(ks[1], (BATCH, D_MODEL), 1.0),
        "w_ada": nrm(ks[2], (L, D_MODEL, 6 * D_MODEL), 0.1 * D_MODEL ** -0.5),
        "b_ada": nrm(ks[3], (L, 6 * D_MODEL), 0.02),
        "w_in": nrm(ks[4], (L, D_MODEL, IN_COLS), D_MODEL ** -0.5),
        "conv_w": nrm(ks[5], (L, CONV_K, M_WIDTH), CONV_K ** -0.5),
        "conv_b": nrm(ks[6], (L, M_WIDTH), 0.02),
        "w_q": nrm(ks[7], (L, M_HEADS, M_HEAD_DIM, M_HEAD_DIM), M_HEAD_DIM ** -0.5),
        "w_k": nrm(ks[8], (L, M_HEADS, M_HEAD_DIM, M_HEAD_DIM), M_HEAD_DIM ** -0.5),
        "w_v": nrm(ks[9], (L, M_HEADS, M_HEAD_DIM, M_HEAD_DIM), M_HEAD_DIM ** -0.5),
        "w_if": nrm(ks[10], (L, 3 * M_WIDTH, 2 * M_HEADS), 0.02),
        "b_if": jnp.concatenate([b_i, b_f], axis=-1),
        "mh_g": 1.0 + nrm(ks[13], (L, M_WIDTH), 0.02),
        "skip": 1.0 + nrm(ks[14], (L, M_WIDTH), 0.02),
        "sg_g": 1.0 + nrm(ks[15], (L, G_WIDTH), 0.02),
        "sg_b": nrm(ks[16], (L, G_WIDTH), 0.02),
        "w_sp": nrm(ks[17], (L, G_GROUPS, SG_CHUNK, SG_CHUNK), SG_CHUNK ** -0.5),
        "b_sp": 1.0 + nrm(ks[18], (L, G_GROUPS, SG_CHUNK), 0.02),
        "w_out": nrm(ks[19], (L, D_MIX, D_MODEL), DN_BETA * D_MIX ** -0.5),
        "ln1_g": 1.0 + nrm(ks[20], (L, D_MODEL), 0.02),
        "ln1_b": nrm(ks[21], (L, D_MODEL), 0.02),
        "w_router": nrm(ks[22], (L, D_MODEL, N_EXPERTS), D_MODEL ** -0.5),
        "e_bias": nrm(ks[23], (L, N_EXPERTS), 0.01),
        "w_gate": nrm(ks[24], (L, N_EXPERTS, D_MODEL, D_EXPERT), D_MODEL ** -0.5),
        "w_up": nrm(ks[25], (L, N_EXPERTS, D_MODEL, D_EXPERT), D_MODEL ** -0.5),
        "w_down": nrm(ks[26], (L, N_EXPERTS, D_EXPERT, D_MODEL), DN_BETA * D_EXPERT ** -0.5),
        "ws_gate": nrm(ks[27], (L, D_MODEL, D_EXPERT), D_MODEL ** -0.5),
        "ws_up": nrm(ks[28], (L, D_MODEL, D_EXPERT), D_MODEL ** -0.5),
        "ws_down": nrm(ks[29], (L, D_EXPERT, D_MODEL), DN_BETA * D_EXPERT ** -0.5),
        "ln2_g": 1.0 + nrm(ks[30], (L, D_MODEL), 0.02),
        "ln2_b": nrm(ks[31], (L, D_MODEL), 0.02),
    }


def reference(x, c, w_ada, b_ada, w_in, conv_w, conv_b, w_q, w_k, w_v, w_if, b_if, mh_g, skip, sg_g, sg_b,
              w_sp, b_sp, w_out, ln1_g, ln1_b, w_router, e_bias, w_gate, w_up, w_down, ws_gate, ws_up, ws_down,
              ln2_g, ln2_b):
    for l in range(DEPTH):
        mod = jax.nn.silu(c) @ w_ada[l] + b_ada[l]
        sh_a, sc_a, gt_a, sh_f, sc_f, gt_f = [m[:, None, :] for m in jnp.split(mod, 6, axis=-1)]
        h = _layernorm(x) * (1.0 + sc_a) + sh_a
        mix = _hybrid_mixer(h, w_in[l], conv_w[l], conv_b[l], w_q[l], w_k[l], w_v[l], w_if[l], b_if[l],
                            mh_g[l], skip[l], sg_g[l], sg_b[l], w_sp[l], b_sp[l], w_out[l])
        x = _layernorm(DN_ALPHA * x + (1.0 + gt_a) * mix) * ln1_g[l] + ln1_b[l]
        h = _layernorm(x) * (1.0 + sc_f) + sh_f
        ffn = _moe(h, w_router[l], e_bias[l], w_gate[l], w_up[l], w_down[l], ws_gate[l], ws_up[l], ws_down[l])
        x = _layernorm(DN_ALPHA * x + (1.0 + gt_f) * ffn) * ln2_g[l] + ln2_b[l]
    return x
```

```cpp
#include <hip/hip_runtime.h>
#include <cstdio>
#include <cstdint>

#ifndef USE_MFMA
#define USE_MFMA 0
#endif

#ifndef ONLYPH
#define ONLYPH -1
#endif
#define PHEN(k) (ONLYPH < 0 || ONLYPH == (k))
#define LAS __attribute__((address_space(3)))
typedef unsigned short bf16;
typedef float f32x4 __attribute__((ext_vector_type(4)));
typedef short bf16x8 __attribute__((ext_vector_type(8)));
typedef unsigned u32x4 __attribute__((ext_vector_type(4)));
typedef unsigned u32x2 __attribute__((ext_vector_type(2)));

constexpr int NB = 4, SEQ = 8192, T = NB * SEQ, D = 1024;
constexpr int NH = 4, DH = 128, LCH = 128, NCH = SEQ / LCH;
constexpr int NE = 256, TOPK = 8, DE = 256;
constexpr float LN_EPS = 1e-5f, DN_ALPHA = 1.189207115002721f, ROUTE_SCALE = 2.5f, KSCALE = 0.08838834764831845f;
constexpr int NPHASE = 13;
constexpr int NTHREADS = 512, NWAVES = 8;
constexpr int LDS_BYTES = 147456;

constexpr size_t MiB = (size_t)1 << 20;
constexpr size_t WS_CTL = 0, CTL_BYTES = 1 * MiB;
constexpr size_t WS_MOD = 1 * MiB;
constexpr size_t WS_WG = 1 * MiB + 128 * 1024;
constexpr size_t WS_WIN = 2 * MiB;
constexpr size_t WS_WOUT = 6 * MiB;
constexpr size_t WS_WQKV = 8 * MiB;
constexpr size_t WS_WR = 9 * MiB;
constexpr size_t WS_WSP = 9 * MiB + 512 * 1024;
constexpr size_t WS_WSG = 10 * MiB;
constexpr size_t WS_WSU = 10 * MiB + 512 * 1024;
constexpr size_t WS_WSD = 11 * MiB;
constexpr size_t WS_WEG = 12 * MiB;
constexpr size_t WS_WEU = 140 * MiB;
constexpr size_t WS_WED = 268 * MiB;
constexpr size_t WS_H2 = 396 * MiB;
constexpr size_t WS_TOPI = 460 * MiB;
constexpr size_t WS_TOPW = 461 * MiB;
constexpr size_t WS_LIST = 462 * MiB;
constexpr size_t WS_LOG = 494 * MiB;
constexpr size_t WS_Y = 512 * MiB;
constexpr size_t WS_HB = 528 * MiB;
constexpr size_t WS_PROJ = 592 * MiB;
constexpr size_t WS_XC = 720 * MiB;
constexpr size_t WS_GATES = 752 * MiB;
constexpr size_t WS_QB = 754 * MiB;
constexpr size_t WS_CLOC = 786 * MiB;
constexpr size_t WS_NUML = 850 * MiB;
constexpr size_t WS_BCUM = 914 * MiB;
constexpr size_t WS_MLOC = 914 * MiB + 512 * 1024;
constexpr size_t WS_DEN = 915 * MiB;
constexpr size_t WS_GCH = 916 * MiB;
constexpr size_t WS_MLS = 916 * MiB + 4096;
constexpr size_t WS_MPREV = 916 * MiB + 8192;
constexpr size_t WS_NLOC = 916 * MiB + 512 * 1024;
constexpr size_t WS_NPREV = 917 * MiB;
constexpr size_t WS_CPREV = 918 * MiB;
constexpr size_t WS_MIX = 950 * MiB;
constexpr size_t WS_MIXO = WS_HB;
constexpr size_t WS_END = 1024 * MiB;

struct Args { const float* in[31]; float* out; unsigned char* ws; int ph_lo, ph_hi; };

__device__ __forceinline__ float bf2f(unsigned v) { return __uint_as_float(v << 16); }
__device__ __forceinline__ unsigned f2bf(float f) { unsigned u = __float_as_uint(f); return (u + 0x7fffu + ((u >> 16) & 1u)) >> 16; }
__device__ __forceinline__ unsigned pk2(float lo, float hi) { return f2bf(lo) | (f2bf(hi) << 16); }
__device__ __forceinline__ float rbf(float f) { return bf2f(f2bf(f)); }
__device__ __forceinline__ void unpack8(const u32x4 v, float (&o)[8]) {
    o[0] = __uint_as_float(v.x << 16); o[1] = __uint_as_float(v.x & 0xffff0000u);
    o[2] = __uint_as_float(v.y << 16); o[3] = __uint_as_float(v.y & 0xffff0000u);
    o[4] = __uint_as_float(v.z << 16); o[5] = __uint_as_float(v.z & 0xffff0000u);
    o[6] = __uint_as_float(v.w << 16); o[7] = __uint_as_float(v.w & 0xffff0000u);
}
__device__ __forceinline__ float wave_sum(float v) {
#pragma unroll
    for (int o = 1; o < 64; o <<= 1) v += __shfl_xor(v, o);
    return v;
}
__device__ __forceinline__ float wave_max(float v) {
#pragma unroll
    for (int o = 1; o < 64; o <<= 1) v = fmaxf(v, __shfl_xor(v, o));
    return v;
}
__device__ __forceinline__ float sigmoid_f(float x) { return 1.0f / (1.0f + __expf(-x)); }
__device__ __forceinline__ float silu_f(float x) { return x / (1.0f + __expf(-x)); }
__device__ __forceinline__ float gelu_f(float x) { return 0.5f * x * (1.0f + erff(x * 0.7071067811865476f)); }
__device__ __forceinline__ float logsigmoid_f(float x) { return fminf(x, 0.f) - log1pf(__expf(-fabsf(x))); }
#define LDS_WAIT() asm volatile("s_waitcnt lgkmcnt(0)" ::: "memory")

template <int CH> __device__ __forceinline__ int toff(int row, int chunk) {
    const int s = (CH == 4) ? ((row >> 1) & 3) : (CH == 8) ? (row & 7) : (row & 15);
    return row * (CH * 16) + ((chunk ^ s) << 4);
}
template <int CH> __device__ __forceinline__ u32x4 ld_chunk(const LAS unsigned char* tile, int row, int chunk) { return *(const LAS u32x4*)(tile + toff<CH>(row, chunk)); }
template <int CH> __device__ __forceinline__ void st_chunk(LAS unsigned char* tile, int row, int chunk, u32x4 v) { *(LAS u32x4*)(tile + toff<CH>(row, chunk)) = v; }
template <int CH> __device__ __forceinline__ float ld_elem(const LAS unsigned char* tile, int row, int col) { return bf2f(*(const LAS unsigned short*)(tile + toff<CH>(row, col >> 3) + (col & 7) * 2)); }
template <int CH> __device__ __forceinline__ void st_elem4(LAS unsigned char* tile, int row, int col  , float a, float b, float c, float d) {
    u32x2 v; v.x = pk2(a, b); v.y = pk2(c, d); *(LAS u32x2*)(tile + toff<CH>(row, col >> 3) + (col & 7) * 2) = v;
}
__device__ __forceinline__ float dot8(const float (&a)[8], const float (&b)[8], float acc) {
#pragma unroll
    for (int i = 0; i < 8; ++i) acc = fmaf(a[i], b[i], acc);
    return acc;
}

template <int NN, class FA, class FB>
__device__ __forceinline__ void core_naive(FA fa, FB fb, int K, f32x4 (&acc)[4][NN]) {
#pragma unroll
    for (int m = 0; m < 4; ++m)
#pragma unroll
        for (int n = 0; n < NN; ++n) acc[m][n] = (f32x4){0.f, 0.f, 0.f, 0.f};
    for (int k8 = 0; k8 < K / 8; ++k8) {
        float af[4][8];
#pragma unroll
        for (int m = 0; m < 4; ++m) unpack8(fa(m, k8), af[m]);
#pragma unroll
        for (int n = 0; n < NN; ++n)
#pragma unroll
            for (int r = 0; r < 4; ++r) {
                float bf[8]; unpack8(fb(n, r, k8), bf);
#pragma unroll
                for (int m = 0; m < 4; ++m) acc[m][n][r] = dot8(af[m], bf, acc[m][n][r]);
                asm volatile("" ::: "memory");
            }
    }
}

__device__ __forceinline__ void transpose_item(const float* W, int K, int N, bf16* WT, float scale, int item, int lane, LAS float* scr) {
    const int nblk = N / 32, kb = item / nblk, nb = item % nblk, k0 = 64 * kb, n0 = 32 * nb;
#pragma unroll 8
    for (int i = 0; i < 32; ++i) { const int kk = 2 * i + (lane >> 5); scr[kk * 33 + (lane & 31)] = W[(size_t)(k0 + kk) * N + n0 + (lane & 31)]; }
    LDS_WAIT();
    const int c = lane & 7;
#pragma unroll
    for (int j = 0; j < 4; ++j) {
        const int n = (lane >> 3) + 8 * j; const LAS float* s = scr + (8 * c) * 33 + n;
        u32x4 o; o.x = pk2(s[0 * 33] * scale, s[1 * 33] * scale); o.y = pk2(s[2 * 33] * scale, s[3 * 33] * scale);
        o.z = pk2(s[4 * 33] * scale, s[5 * 33] * scale); o.w = pk2(s[6 * 33] * scale, s[7 * 33] * scale);
        *(u32x4*)(WT + (size_t)(n0 + n) * K + k0 + 8 * c) = o;
    }
    LDS_WAIT();
}

__device__ __forceinline__ void phase_prep(const Args& a, LAS unsigned char* lds, int tid, int lane, int wave, int vcu, int G) {
    unsigned char* ws = a.ws;
    {
        LAS float* scr = (LAS float*)(lds + wave * 16384);
        const int gw = vcu * NWAVES + wave, NGW = G * NWAVES;
        constexpr int NITEMS = 1024 + 512 + 96 + 128 + 384 + 3 * 32768;
        for (int it = gw; it < NITEMS; it += NGW) {
            int r = it;
            if (r < 1024) { transpose_item(a.in[4], 1024, 2048, (bf16*)(ws + WS_WIN), 1.f, r, lane, scr); continue; } r -= 1024;
            if (r < 512) { transpose_item(a.in[18], 1024, 1024, (bf16*)(ws + WS_WOUT), 1.f, r, lane, scr); continue; } r -= 512;
            if (r < 96) { const int which = r / 32, rr = r % 32, h = rr / 8, ii = rr % 8;
                const float* src = (which == 0 ? a.in[7] : which == 1 ? a.in[8] : a.in[9]) + h * 16384;
                transpose_item(src, 128, 128, (bf16*)(ws + WS_WQKV) + (which * 4 + h) * 16384, which == 1 ? KSCALE : 1.f, ii, lane, scr); continue; } r -= 96;
            if (r < 128) { transpose_item(a.in[21], 1024, 256, (bf16*)(ws + WS_WR), 1.f, r, lane, scr); continue; } r -= 128;
            if (r < 128) { transpose_item(a.in[26], 1024, 256, (bf16*)(ws + WS_WSG), 1.f, r, lane, scr); continue; } r -= 128;
            if (r < 128) { transpose_item(a.in[27], 1024, 256, (bf16*)(ws + WS_WSU), 1.f, r, lane, scr); continue; } r -= 128;
            if (r < 128) { transpose_item(a.in[28], 256, 1024, (bf16*)(ws + WS_WSD), 1.f, r, lane, scr); continue; } r -= 128;
            if (r < 32768) { const int e = r >> 7; transpose_item(a.in[23] + (size_t)e * 262144, 1024, 256, (bf16*)(ws + WS_WEG) + (size_t)e * 262144, 1.f, r & 127, lane, scr); continue; } r -= 32768;
            if (r < 32768) { const int e = r >> 7; transpose_item(a.in[24] + (size_t)e * 262144, 1024, 256, (bf16*)(ws + WS_WEU) + (size_t)e * 262144, 1.f, r & 127, lane, scr); continue; } r -= 32768;
            { const int e = r >> 7; transpose_item(a.in[25] + (size_t)e * 262144, 256, 1024, (bf16*)(ws + WS_WED) + (size_t)e * 262144, 1.f, r & 127, lane, scr); }
        }
    }
    __syncthreads();
    {
        LAS float* sc = (LAS float*)lds;
        LAS float* part = (LAS float*)(lds + 16384);
        for (int it = vcu; it < 96; it += G) {
            __syncthreads();
            for (int i = tid; i < 4096; i += NTHREADS) sc[i] = silu_f(a.in[1][i]);
            __syncthreads();
            const int col = it * 64 + lane;
            float s0 = 0.f, s1 = 0.f, s2 = 0.f, s3 = 0.f;
            const float* wp = a.in[2] + (size_t)(wave * 128) * 6144 + col;
#pragma unroll 8
            for (int k = 0; k < 128; ++k) { const float w = wp[(size_t)k * 6144]; const int kk = wave * 128 + k;
                s0 = fmaf(sc[kk], w, s0); s1 = fmaf(sc[1024 + kk], w, s1); s2 = fmaf(sc[2048 + kk], w, s2); s3 = fmaf(sc[3072 + kk], w, s3); }
            part[(wave * 4 + 0) * 64 + lane] = s0; part[(wave * 4 + 1) * 64 + lane] = s1; part[(wave * 4 + 2) * 64 + lane] = s2; part[(wave * 4 + 3) * 64 + lane] = s3;
            __syncthreads();
            if (tid < 256) { const int b = tid >> 6, cl = tid & 63; float s = a.in[3][it * 64 + cl];
#pragma unroll
                for (int w = 0; w < 8; ++w) s += part[(w * 4 + b) * 64 + cl];
                ((float*)(ws + WS_MOD))[b * 6144 + it * 64 + cl] = s; }
        }
        __syncthreads();
    }
    {
        const int gt = vcu * NTHREADS + tid, NGT = G * NTHREADS;
        bf16* wsp = (bf16*)(ws + WS_WSP);
        for (int i = gt; i < 65536; i += NGT) { const int t = (i >> 7) & 127, s = i & 127; wsp[i] = (s <= t) ? (bf16)f2bf(a.in[16][i]) : (bf16)0; }
        float* wg = (float*)(ws + WS_WG);
        const float* wq = a.in[7]; const float* wk = a.in[8]; const float* wv = a.in[9]; const float* wif = a.in[10];
        for (int i = gt; i < 8192; i += NGT) {
            const int row = i >> 3, j = i & 7; float s = 0.f;
            if (row < 512) { const int h = row >> 7, d = row & 127; float sq = 0.f, sk = 0.f;
                for (int e = 0; e < 128; ++e) { sq = fmaf(wq[(h * 128 + d) * 128 + e], wif[(h * 128 + e) * 8 + j], sq); sk = fmaf(wk[(h * 128 + d) * 128 + e], wif[(512 + h * 128 + e) * 8 + j], sk); }
                s = sq + KSCALE * sk; }
            else { const int ch = row - 512, h = ch >> 7, d = ch & 127;
                for (int e = 0; e < 128; ++e) s = fmaf(wv[(h * 128 + d) * 128 + e], wif[(1024 + h * 128 + e) * 8 + j], s); }
            wg[i] = s;
        }
    }
}

__device__ __forceinline__ void phase_ln1(const Args& a, int lane, int gw, int NGW) {
    const float* mod = (const float*)(a.ws + WS_MOD); bf16* hb = (bf16*)(a.ws + WS_HB);
    for (int row = gw; row < T; row += NGW) {
        const int b = row >> 13;
        const f32x4* xr = (const f32x4*)(a.in[0] + (size_t)row * D) + lane;
        f32x4 v[4]; float s = 0.f;
#pragma unroll
        for (int j = 0; j < 4; ++j) { v[j] = xr[64 * j]; s += (v[j].x + v[j].y) + (v[j].z + v[j].w); }
        const float mean = wave_sum(s) * (1.f / D); float s2 = 0.f;
#pragma unroll
        for (int j = 0; j < 4; ++j) { v[j] = v[j] - mean; s2 += (v[j].x * v[j].x + v[j].y * v[j].y) + (v[j].z * v[j].z + v[j].w * v[j].w); }
        const float rstd = 1.f / sqrtf(wave_sum(s2) * (1.f / D) + LN_EPS);
        u32x2* o8 = (u32x2*)(hb + (size_t)row * D) + lane;
#pragma unroll
        for (int j = 0; j < 4; ++j) { const int col = 4 * lane + 256 * j;
            const f32x4 sh = *(const f32x4*)(mod + b * 6144 + col), sc = *(const f32x4*)(mod + b * 6144 + 1024 + col);
            const f32x4 h = v[j] * rstd * (sc + 1.0f) + sh; u32x2 w; w.x = pk2(h.x, h.y); w.y = pk2(h.z, h.w); o8[64 * j] = w; }
    }
}

template <class Epi>
__device__ __forceinline__ void phase_gemm_dense(const bf16* A, const bf16* Bt, int Mrows, int N, int K, LAS unsigned char* lds, int tid, int lane, int wave, int vcu, int G, Epi epi) {
    const int nM = Mrows / 256, nN = N / 256, wm = wave >> 1, wn = wave & 1, fr = lane & 15, fq = lane >> 4;
    for (int it = vcu; it < nM * nN; it += G) {
        const int pm = it / nN, pn = it % nN;
        const bf16* Ab = A + (size_t)(pm * 256 + wm * 64 + fr) * K;
        const bf16* Bb = Bt + (size_t)(pn * 256 + wn * 128 + 4 * fq) * K;
#pragma unroll 1
        for (int nq = 0; nq < 4; ++nq) {
            f32x4 acc[4][2];
            core_naive<2>([&](int m, int k8) { return *(const u32x4*)(Ab + (size_t)(16 * m) * K + 8 * k8); },
                          [&](int n, int r, int k8) { return *(const u32x4*)(Bb + (size_t)(16 * (2 * nq + n) + r) * K + 8 * k8); }, K, acc);
#pragma unroll
            for (int m = 0; m < 4; ++m)
#pragma unroll
                for (int n = 0; n < 2; ++n) epi(pm * 256 + wm * 64 + 16 * m + fr, pn * 256 + wn * 128 + 16 * (2 * nq + n) + 4 * fq, acc[m][n]);
        }
    }
}

__device__ __forceinline__ void phase_conv_gates(const Args& a, int lane, int gw, int NGW) {
    const bf16* proj = (const bf16*)(a.ws + WS_PROJ); bf16* xcb = (bf16*)(a.ws + WS_XC); float* gates = (float*)(a.ws + WS_GATES);
    const float* wg = (const float*)(a.ws + WS_WG); const float* cw = a.in[5]; const float* cb = a.in[6]; const float* bif = a.in[11];
    const int ch = lane * 8;
    for (int tok = gw; tok < T; tok += NGW) {
        const int ts = tok & (SEQ - 1);
        float acc[8], xm[8];
#pragma unroll
        for (int i = 0; i < 8; ++i) { acc[i] = cb[ch + i]; xm[i] = 0.f; }
#pragma unroll
        for (int j = 0; j < 4; ++j) {
            if (ts - 3 + j >= 0) {
                float v[8]; unpack8(*(const u32x4*)(proj + (size_t)(tok - 3 + j) * 2048 + ch), v);
#pragma unroll
                for (int i = 0; i < 8; ++i) { acc[i] = fmaf(cw[j * 512 + ch + i], v[i], acc[i]); if (j == 3) xm[i] = v[i]; }
            }
        }
        float xc[8];
#pragma unroll
        for (int i = 0; i < 8; ++i) xc[i] = rbf(silu_f(acc[i]));
        u32x4 o; o.x = pk2(xc[0], xc[1]); o.y = pk2(xc[2], xc[3]); o.z = pk2(xc[4], xc[5]); o.w = pk2(xc[6], xc[7]);
        *(u32x4*)(xcb + (size_t)tok * 512 + ch) = o;
        float g[8];
#pragma unroll
        for (int j = 0; j < 8; ++j) g[j] = 0.f;
#pragma unroll
        for (int i = 0; i < 8; ++i) {
            const f32x4 w1a = *(const f32x4*)(wg + (ch + i) * 8), w1b = *(const f32x4*)(wg + (ch + i) * 8 + 4);
            const f32x4 w2a = *(const f32x4*)(wg + (512 + ch + i) * 8), w2b = *(const f32x4*)(wg + (512 + ch + i) * 8 + 4);
            g[0] += xc[i] * w1a.x + xm[i] * w2a.x; g[1] += xc[i] * w1a.y + xm[i] * w2a.y; g[2] += xc[i] * w1a.z + xm[i] * w2a.z; g[3] += xc[i] * w1a.w + xm[i] * w2a.w;
            g[4] += xc[i] * w1b.x + xm[i] * w2b.x; g[5] += xc[i] * w1b.y + xm[i] * w2b.y; g[6] += xc[i] * w1b.z + xm[i] * w2b.z; g[7] += xc[i] * w1b.w + xm[i] * w2b.w;
        }
#pragma unroll
        for (int j = 0; j < 8; ++j) g[j] = wave_sum(g[j]);
        if (lane == 0) {
            f32x4 o0 = {g[0] + bif[0], g[1] + bif[1], g[2] + bif[2], g[3] + bif[3]}, o1 = {g[4] + bif[4], g[5] + bif[5], g[6] + bif[6], g[7] + bif[7]};
            *(f32x4*)(gates + (size_t)tok * 8) = o0; *(f32x4*)(gates + (size_t)tok * 8 + 4) = o1;
        }
    }
}

__device__ __forceinline__ void mm_nt_g(const LAS unsigned char* A, const bf16* Bg, int tid, float (&o)[32]) {
    const int t = tid >> 2, j0 = (tid & 3) * 32;
#pragma unroll
    for (int i = 0; i < 32; ++i) o[i] = 0.f;
    for (int c = 0; c < 16; ++c) {
        float af[8]; unpack8(ld_chunk<16>(A, t, c), af);
#pragma unroll
        for (int i = 0; i < 32; ++i) { float bf[8]; unpack8(*(const u32x4*)(Bg + (size_t)(j0 + i) * 128 + 8 * c), bf); o[i] = dot8(af, bf, o[i]); if ((i & 3) == 3) asm volatile("" ::: "memory"); }
    }
}
__device__ __forceinline__ void mm_nt_l(const LAS unsigned char* A, const LAS unsigned char* B, int tid, float (&o)[32]) {
    const int t = tid >> 2, j0 = (tid & 3) * 32;
#pragma unroll
    for (int i = 0; i < 32; ++i) o[i] = 0.f;
    for (int c = 0; c < 16; ++c) {
        float af[8]; unpack8(ld_chunk<16>(A, t, c), af);
#pragma unroll
        for (int i = 0; i < 32; ++i) { float bf[8]; unpack8(ld_chunk<16>(B, j0 + i, c), bf); o[i] = dot8(af, bf, o[i]); if ((i & 3) == 3) asm volatile("" ::: "memory"); }
    }
}
__device__ __forceinline__ void mm_nn_l(const LAS unsigned char* P, const LAS unsigned char* V, int tid, int slim, float (&o)[32]) {
    const int t = tid >> 2, c0 = (tid & 3) * 4;
#pragma unroll
    for (int i = 0; i < 32; ++i) o[i] = 0.f;
    for (int s = 0; s < slim; ++s) {
        const float p = ld_elem<16>(P, t, s);
#pragma unroll
        for (int cc = 0; cc < 4; ++cc) { float vf[8]; unpack8(ld_chunk<16>(V, s, c0 + cc), vf);
#pragma unroll
            for (int e = 0; e < 8; ++e) o[cc * 8 + e] = fmaf(p, vf[e], o[cc * 8 + e]); }
    }
}

__device__ __forceinline__ void phase_mlstm_local(const Args& a, LAS unsigned char* lds, int tid, int vcu, int G) {
    unsigned char* ws = a.ws;
    const bf16* proj = (const bf16*)(ws + WS_PROJ); const bf16* xcb = (const bf16*)(ws + WS_XC); const float* gates = (const float*)(ws + WS_GATES);
    bf16* qb = (bf16*)(ws + WS_QB); float* cloc = (float*)(ws + WS_CLOC); float* numl = (float*)(ws + WS_NUML);
    LAS unsigned char* TX = lds; LAS unsigned char* TQ = lds + 32768; LAS unsigned char* TK = lds + 65536; LAS unsigned char* TV = lds + 98304;
    LAS float* F = (LAS float*)(lds + 131072);
    LAS float* ipre = F; LAS float* bcum = F + 128; LAS float* wexp = F + 256; LAS float* uu = F + 384; LAS float* cm = F + 512; LAS float* misc = F + 640;
    const int t = tid >> 2, j0 = (tid & 3) * 32;
    for (int it = vcu; it < NB * NCH * NH; it += G) {
        const int h = it & 3, c = (it >> 2) & 63, b = it >> 8;
        const int t0 = b * SEQ + c * LCH; const int bhc = (b * NH + h) * NCH + c;
        __syncthreads();
        for (int i = tid; i < 2048; i += NTHREADS) { const int r = i >> 4, ch = i & 15; st_chunk<16>(TX, r, ch, *(const u32x4*)(xcb + (size_t)(t0 + r) * 512 + h * 128 + ch * 8)); }
        if (tid < 128) {
            const float ip = gates[(size_t)(t0 + tid) * 8 + h], fp = gates[(size_t)(t0 + tid) * 8 + 4 + h];
            ipre[tid] = ip; bcum[tid] = logsigmoid_f(fp);
        }
        __syncthreads();
        if (tid == 0) {
            float s = 0.f; for (int i = 0; i < 128; ++i) { s += bcum[i]; bcum[i] = s; }
            const float g = s; float mx = -3.0e38f, run = -3.0e38f;
            for (int i = 0; i < 128; ++i) { const float av = g - bcum[i] + ipre[i]; wexp[i] = av; mx = fmaxf(mx, av); const float u = ipre[i] - bcum[i]; uu[i] = u; run = fmaxf(run, u); cm[i] = run; }
            for (int i = 0; i < 128; ++i) wexp[i] = __expf(wexp[i] - mx);
            misc[0] = g; misc[1] = mx;
            ((float*)(ws + WS_GCH))[bhc] = g; ((float*)(ws + WS_MLS))[bhc] = mx;
        }
        float o[32];
        mm_nt_g(TX, (const bf16*)(ws + WS_WQKV) + (0 * 4 + h) * 16384, tid, o);
#pragma unroll
        for (int i = 0; i < 32; i += 4) st_elem4<16>(TQ, t, j0 + i, o[i], o[i + 1], o[i + 2], o[i + 3]);
#pragma unroll
        for (int i = 0; i < 32; i += 8) { u32x4 w; w.x = pk2(o[i], o[i + 1]); w.y = pk2(o[i + 2], o[i + 3]); w.z = pk2(o[i + 4], o[i + 5]); w.w = pk2(o[i + 6], o[i + 7]);
            *(u32x4*)(qb + (size_t)(t0 + t) * 512 + h * 128 + j0 + i) = w; }
        mm_nt_g(TX, (const bf16*)(ws + WS_WQKV) + (1 * 4 + h) * 16384, tid, o);
#pragma unroll
        for (int i = 0; i < 32; i += 4) st_elem4<16>(TK, t, j0 + i, o[i], o[i + 1], o[i + 2], o[i + 3]);
        __syncthreads();
        for (int i = tid; i < 2048; i += NTHREADS) { const int r = i >> 4, ch = i & 15; st_chunk<16>(TX, r, ch, *(const u32x4*)(proj + (size_t)(t0 + r) * 2048 + h * 128 + ch * 8)); }
        __syncthreads();
        mm_nt_g(TX, (const bf16*)(ws + WS_WQKV) + (2 * 4 + h) * 16384, tid, o);
#pragma unroll
        for (int i = 0; i < 32; i += 4) st_elem4<16>(TV, t, j0 + i, o[i], o[i + 1], o[i + 2], o[i + 3]);
        __syncthreads();
        {
#pragma unroll
            for (int i = 0; i < 32; ++i) o[i] = 0.f;
            for (int l = 0; l < 128; ++l) {
                const float vv = ld_elem<16>(TV, l, t) * wexp[l];
#pragma unroll
                for (int cc = 0; cc < 4; ++cc) { float kf[8]; unpack8(ld_chunk<16>(TK, l, (tid & 3) * 4 + cc), kf);
#pragma unroll
                    for (int e = 0; e < 8; ++e) o[cc * 8 + e] = fmaf(vv, kf[e], o[cc * 8 + e]); }
            }
            float* cp = cloc + (size_t)bhc * 16384 + t * 128 + j0;
#pragma unroll
            for (int i = 0; i < 32; i += 4) *(f32x4*)(cp + i) = (f32x4){o[i], o[i + 1], o[i + 2], o[i + 3]};
            if (tid < 128) { float s = 0.f; for (int l = 0; l < 128; ++l) s = fmaf(wexp[l], ld_elem<16>(TK, l, tid), s); ((float*)(ws + WS_NLOC))[(size_t)bhc * 128 + tid] = s; }
        }
        mm_nt_l(TQ, TK, tid, o);
        float den = 0.f;
        {
            const float cmt = cm[t];
#pragma unroll
            for (int i = 0; i < 32; ++i) { const int s = j0 + i; float p = (s <= t) ? __expf(uu[s] - cmt) * o[i] : 0.f; p = rbf(p); o[i] = p; den += p; }
            den += __shfl_xor(den, 1); den += __shfl_xor(den, 2);
        }
        __syncthreads();
#pragma unroll
        for (int i = 0; i < 32; i += 4) st_elem4<16>(TX, t, j0 + i, o[i], o[i + 1], o[i + 2], o[i + 3]);
        __syncthreads();
        mm_nn_l(TX, TV, tid, 128, o);
        {
            float* np = numl + (size_t)(t0 + t) * 512 + h * 128 + j0;
#pragma unroll
            for (int i = 0; i < 32; i += 4) *(f32x4*)(np + i) = (f32x4){o[i], o[i + 1], o[i + 2], o[i + 3]};
            if ((tid & 3) == 0) {
                ((float*)(ws + WS_BCUM))[(size_t)(t0 + t) * 4 + h] = bcum[t];
                ((float*)(ws + WS_MLOC))[(size_t)(t0 + t) * 4 + h] = bcum[t] + cm[t];
                ((float*)(ws + WS_DEN))[(size_t)(t0 + t) * 4 + h] = den;
            }
        }
    }
}

__device__ __forceinline__ void phase_scan(const Args& a, int tid, int vcu, int G) {
    unsigned char* ws = a.ws;
    const float* gch = (const float*)(ws + WS_GCH); const float* mls = (const float*)(ws + WS_MLS);
    const float* cloc = (const float*)(ws + WS_CLOC); bf16* cprev = (bf16*)(ws + WS_CPREV);
    const float* nloc = (const float*)(ws + WS_NLOC); float* nprev = (float*)(ws + WS_NPREV); float* mprev = (float*)(ws + WS_MPREV);
    for (int it = vcu; it < 512 + 4; it += G) {
        if (it < 512) {
            const int bh = it >> 5, e = (it & 31) * 512 + tid;
            float m = 0.f, C = 0.f;
            for (int c = 0; c < NCH; ++c) {
                const size_t idx = (size_t)(bh * NCH + c) * 16384 + e;
                cprev[idx] = (bf16)f2bf(C);
                const float g = gch[bh * NCH + c], ml = mls[bh * NCH + c], mn = fmaxf(g + m, ml);
                C = __expf(g + m - mn) * C + __expf(ml - mn) * cloc[idx]; m = mn;
            }
        } else {
            const int gi = (it - 512) * 512 + tid, bh = gi >> 7, e = gi & 127;
            float m = 0.f, n = 0.f;
            for (int c = 0; c < NCH; ++c) {
                const size_t idx = (size_t)(bh * NCH + c) * 128 + e;
                nprev[idx] = n; if (e == 0) mprev[bh * NCH + c] = m;
                const float g = gch[bh * NCH + c], ml = mls[bh * NCH + c], mn = fmaxf(g + m, ml);
                n = __expf(g + m - mn) * n + __expf(ml - mn) * nloc[idx]; m = mn;
            }
        }
    }
}

__device__ __forceinline__ void phase_mixer_out(const Args& a, LAS unsigned char* lds, int tid, int vcu, int G) {
    unsigned char* ws = a.ws;
    const bf16* proj = (const bf16*)(ws + WS_PROJ); const bf16* xcb = (const bf16*)(ws + WS_XC); const bf16* qb = (const bf16*)(ws + WS_QB);
    const bf16* cprev = (const bf16*)(ws + WS_CPREV); const float* numl = (const float*)(ws + WS_NUML); bf16* mix = (bf16*)(ws + WS_MIX);
    LAS unsigned char* TQ = lds; LAS unsigned char* TC = lds + 32768; LAS unsigned char* TV = lds + 65536;
    const int t = tid >> 2, j0 = (tid & 3) * 32;
    for (int it = vcu; it < NB * NCH * NH; it += G) {
        const int h = it & 3, c = (it >> 2) & 63, b = it >> 8;
        const int t0 = b * SEQ + c * LCH; const int bhc = (b * NH + h) * NCH + c; const int tok = t0 + t;
        __syncthreads();
        for (int i = tid; i < 2048; i += NTHREADS) { const int r = i >> 4, ch = i & 15;
            st_chunk<16>(TQ, r, ch, *(const u32x4*)(qb + (size_t)(t0 + r) * 512 + h * 128 + ch * 8));
            st_chunk<16>(TC, r, ch, *(const u32x4*)(cprev + (size_t)bhc * 16384 + r * 128 + ch * 8)); }
        {
            float vg[32]; float s = 0.f;
#pragma unroll
            for (int i = 0; i < 32; i += 8) { float vf[8];
                unpack8(*(const u32x4*)(proj + (size_t)tok * 2048 + 1536 + h * 128 + j0 + i), vf);
#pragma unroll
                for (int e = 0; e < 8; ++e) { vg[i + e] = gelu_f(vf[e]); s += vg[i + e]; } }
            s += __shfl_xor(s, 1); s += __shfl_xor(s, 2);
            const float mean = s * (1.f / 128.f); float q = 0.f;
#pragma unroll
            for (int i = 0; i < 32; ++i) { vg[i] -= mean; q += vg[i] * vg[i]; }
            q += __shfl_xor(q, 1); q += __shfl_xor(q, 2);
            const float rstd = 1.f / sqrtf(q * (1.f / 128.f) + LN_EPS);
#pragma unroll
            for (int i = 0; i < 32; ++i) vg[i] = vg[i] * rstd * a.in[14][h * 128 + j0 + i] + a.in[15][h * 128 + j0 + i];
#pragma unroll
            for (int i = 0; i < 32; i += 4) st_elem4<16>(TV, t, j0 + i, vg[i], vg[i + 1], vg[i + 2], vg[i + 3]);
        }
        __syncthreads();
        float o[32];
        mm_nt_l(TQ, TC, tid, o);
        {
            float nqi = 0.f;
            const float* np = (const float*)(ws + WS_NPREV) + (size_t)bhc * 128;
#pragma unroll
            for (int i = 0; i < 32; ++i) nqi = fmaf(ld_elem<16>(TQ, t, j0 + i), np[j0 + i], nqi);
            nqi += __shfl_xor(nqi, 1); nqi += __shfl_xor(nqi, 2);
            const float mp = ((const float*)(ws + WS_MPREV))[bhc];
            const float bc = ((const float*)(ws + WS_BCUM))[(size_t)tok * 4 + h], ml = ((const float*)(ws + WS_MLOC))[(size_t)tok * 4 + h], den = ((const float*)(ws + WS_DEN))[(size_t)tok * 4 + h];
            const float mt = fmaxf(bc + mp, ml), wi = __expf(bc + mp - mt), wl = __expf(ml - mt);
            const float nq = wi * nqi + wl * den, dn = 1.f / fmaxf(fabsf(nq), __expf(-mt));
            const float* nlp = numl + (size_t)tok * 512 + h * 128 + j0;
            float s = 0.f;
#pragma unroll
            for (int i = 0; i < 32; ++i) { o[i] = (wi * o[i] + wl * nlp[i]) * dn; s += o[i]; }
            s += __shfl_xor(s, 1); s += __shfl_xor(s, 2);
            const float mean = s * (1.f / 128.f); float q = 0.f;
#pragma unroll
            for (int i = 0; i < 32; ++i) { o[i] -= mean; q += o[i] * o[i]; }
            q += __shfl_xor(q, 1); q += __shfl_xor(q, 2);
            const float rstd = 1.f / sqrtf(q * (1.f / 128.f) + LN_EPS);
#pragma unroll
            for (int i = 0; i < 32; i += 8) {
                float zf[8], xf[8], r[8];
                unpack8(*(const u32x4*)(proj + (size_t)tok * 2048 + 512 + h * 128 + j0 + i), zf); unpack8(*(const u32x4*)(xcb + (size_t)tok * 512 + h * 128 + j0 + i), xf);
#pragma unroll
                for (int e = 0; e < 8; ++e) { const int ch = h * 128 + j0 + i + e; const float hc = o[i + e] * rstd * a.in[12][ch]; r[e] = sigmoid_f(zf[e]) * (hc + a.in[13][ch] * xf[e]); }
                u32x4 w; w.x = pk2(r[0], r[1]); w.y = pk2(r[2], r[3]); w.z = pk2(r[4], r[5]); w.w = pk2(r[6], r[7]);
                *(u32x4*)(mix + (size_t)tok * 1024 + h * 128 + j0 + i) = w;
            }
        }
        {
            const bf16* wrow = (const bf16*)(ws + WS_WSP) + (size_t)h * 16384 + t * 128;
#pragma unroll
            for (int i = 0; i < 32; ++i) o[i] = 0.f;
            for (int s = 0; s <= t; ++s) {
                const float p = bf2f(wrow[s]);
#pragma unroll
                for (int cc = 0; cc < 4; ++cc) { float vf[8]; unpack8(ld_chunk<16>(TV, s, (tid & 3) * 4 + cc), vf);
#pragma unroll
                    for (int e = 0; e < 8; ++e) o[cc * 8 + e] = fmaf(p, vf[e], o[cc * 8 + e]); }
            }
            const float bsp = a.in[17][h * 128 + t];
#pragma unroll
            for (int i = 0; i < 32; i += 8) { u32x4 w; float ug[8];
                unpack8(*(const u32x4*)(proj + (size_t)tok * 2048 + 1024 + h * 128 + j0 + i), ug);
#pragma unroll
                for (int e = 0; e < 8; ++e) ug[e] = gelu_f(ug[e]);
                w.x = pk2(ug[0] * (o[i] + bsp), ug[1] * (o[i + 1] + bsp)); w.y = pk2(ug[2] * (o[i + 2] + bsp), ug[3] * (o[i + 3] + bsp));
                w.z = pk2(ug[4] * (o[i + 4] + bsp), ug[5] * (o[i + 5] + bsp)); w.w = pk2(ug[6] * (o[i + 6] + bsp), ug[7] * (o[i + 7] + bsp));
                *(u32x4*)(mix + (size_t)tok * 1024 + 512 + h * 128 + j0 + i) = w; }
        }
    }
}

__device__ __forceinline__ void phase_ln2(const Args& a, int lane, int gw, int NGW) {
    const float* mod = (const float*)(a.ws + WS_MOD); const bf16* mixo = (const bf16*)(a.ws + WS_MIXO); bf16* h2 = (bf16*)(a.ws + WS_H2);
    for (int row = gw; row < T; row += NGW) {
        const int b = row >> 13;
        const f32x4* xr = (const f32x4*)(a.in[0] + (size_t)row * D) + lane; const u32x2* mr = (const u32x2*)(mixo + (size_t)row * D) + lane;
        f32x4 v[4]; float s = 0.f;
#pragma unroll
        for (int j = 0; j < 4; ++j) { const int col = 4 * lane + 256 * j; const f32x4 x = xr[64 * j]; const u32x2 m = mr[64 * j];
            const f32x4 gt = *(const f32x4*)(mod + b * 6144 + 2048 + col);
            const f32x4 mv = {bf2f(m.x & 0xffffu), bf2f(m.x >> 16), bf2f(m.y & 0xffffu), bf2f(m.y >> 16)};
            v[j] = x * DN_ALPHA + (gt + 1.0f) * mv; s += (v[j].x + v[j].y) + (v[j].z + v[j].w); }
        float mean = wave_sum(s) * (1.f / D), s2 = 0.f;
#pragma unroll
        for (int j = 0; j < 4; ++j) { v[j] = v[j] - mean; s2 += (v[j].x * v[j].x + v[j].y * v[j].y) + (v[j].z * v[j].z + v[j].w * v[j].w); }
        float rstd = 1.f / sqrtf(wave_sum(s2) * (1.f / D) + LN_EPS);
        f32x4* xo = (f32x4*)(a.out + (size_t)row * D) + lane; s = 0.f;
#pragma unroll
        for (int j = 0; j < 4; ++j) { const int col = 4 * lane + 256 * j;
            v[j] = v[j] * rstd * *(const f32x4*)(a.in[19] + col) + *(const f32x4*)(a.in[20] + col); xo[64 * j] = v[j]; s += (v[j].x + v[j].y) + (v[j].z + v[j].w); }
        mean = wave_sum(s) * (1.f / D); s2 = 0.f;
#pragma unroll
        for (int j = 0; j < 4; ++j) { v[j] = v[j] - mean; s2 += (v[j].x * v[j].x + v[j].y * v[j].y) + (v[j].z * v[j].z + v[j].w * v[j].w); }
        rstd = 1.f / sqrtf(wave_sum(s2) * (1.f / D) + LN_EPS);
        u32x2* o8 = (u32x2*)(h2 + (size_t)row * D) + lane;
#pragma unroll
        for (int j = 0; j < 4; ++j) { const int col = 4 * lane + 256 * j;
            const f32x4 sh = *(const f32x4*)(mod + b * 6144 + 3072 + col), sc = *(const f32x4*)(mod + b * 6144 + 4096 + col);
            const f32x4 h = v[j] * rstd * (sc + 1.0f) + sh; u32x2 w; w.x = pk2(h.x, h.y); w.y = pk2(h.z, h.w); o8[64 * j] = w; }
    }
}

__device__ __forceinline__ void phase_route(const Args& a, int lane, int gw, int NGW) {
    unsigned char* ws = a.ws;
    const float* logits = (const float*)(ws + WS_LOG); const float* ebias = a.in[22];
    unsigned* cnt = (unsigned*)(ws + WS_CTL); int* topi = (int*)(ws + WS_TOPI); float* topw = (float*)(ws + WS_TOPW); int* list = (int*)(ws + WS_LIST);
    const f32x4 eb = *(const f32x4*)(ebias + lane * 4);
    for (int tok = gw; tok < T; tok += NGW) {
        const f32x4 lg = *(const f32x4*)(logits + (size_t)tok * 256 + lane * 4);
        float sc[4] = {sigmoid_f(lg.x), sigmoid_f(lg.y), sigmoid_f(lg.z), sigmoid_f(lg.w)};
        float sel[4] = {sc[0] + eb.x, sc[1] + eb.y, sc[2] + eb.z, sc[3] + eb.w};
        float m1 = fmaxf(sel[0], sel[1]), m2 = fminf(sel[0], sel[1]);
        { const float c = sel[2]; if (c > m1) { m2 = m1; m1 = c; } else if (c > m2) m2 = c; }
        { const float c = sel[3]; if (c > m1) { m2 = m1; m1 = c; } else if (c > m2) m2 = c; }
#pragma unroll
        for (int o = 1; o < 8; o <<= 1) { const float b1 = __shfl_xor(m1, o), b2 = __shfl_xor(m2, o); const float n1 = fmaxf(m1, b1), n2 = fmaxf(fminf(m1, b1), fmaxf(m2, b2)); m1 = n1; m2 = n2; }
        const float gs = m1 + m2; const int mygrp = lane >> 3; int rank = 0;
#pragma unroll
        for (int g = 0; g < 8; ++g) { const float og = __shfl(gs, g * 8); rank += (og > gs || (og == gs && g < mygrp)) ? 1 : 0; }
        const bool allowed = rank < 4;
#pragma unroll
        for (int i = 0; i < 4; ++i) if (!allowed) sel[i] = -INFINITY;
        int myE = 0; float myS = 0.f, ssum = 0.f;
#pragma unroll 1
        for (int k = 0; k < TOPK; ++k) {
            float bv = sel[0]; int bi = lane * 4;
            if (sel[1] > bv) { bv = sel[1]; bi = lane * 4 + 1; }
            if (sel[2] > bv) { bv = sel[2]; bi = lane * 4 + 2; }
            if (sel[3] > bv) { bv = sel[3]; bi = lane * 4 + 3; }
#pragma unroll
            for (int o = 1; o < 64; o <<= 1) { const float ov = __shfl_xor(bv, o); const int oi = __shfl_xor(bi, o); if (ov > bv || (ov == bv && oi < bi)) { bv = ov; bi = oi; } }
            const int sub = bi & 3; const float mysc = sub == 0 ? sc[0] : sub == 1 ? sc[1] : sub == 2 ? sc[2] : sc[3];
            const float wsc = __shfl(mysc, bi >> 2);
            if ((bi >> 2) == lane) { if (sub == 0) sel[0] = -INFINITY; else if (sub == 1) sel[1] = -INFINITY; else if (sub == 2) sel[2] = -INFINITY; else sel[3] = -INFINITY; }
            if (lane == k) { myE = bi; myS = wsc; }
            ssum += wsc;
        }
        if (lane < TOPK) {
            const float w = myS / ssum * ROUTE_SCALE;
            topi[(size_t)tok * 8 + lane] = myE; topw[(size_t)tok * 8 + lane] = w;
            const unsigned pos = atomicAdd(&cnt[myE], 1u);
            list[(size_t)myE * 32768 + pos] = tok * 8 + lane;
        }
    }
}

template <bool SHARED>
__device__ __forceinline__ void moe_item(const Args& a, LAS unsigned char* HT, const LAS int* sEnt, const LAS float* sW, const bf16* Wg, const bf16* Wu, const bf16* Wd, int lane, int wave) {
    unsigned char* ws = a.ws;
    const bf16* h2 = (const bf16*)(ws + WS_H2); bf16* Y = (bf16*)(ws + WS_Y); const float* mod = (const float*)(ws + WS_MOD);
    const int wm = wave >> 2, wn = wave & 3, fr = lane & 15, fq = lane >> 4;
    {
        const bf16* arow[4];
#pragma unroll
        for (int m = 0; m < 4; ++m) { int ent = sEnt[wm * 64 + 16 * m + fr]; if (ent < 0) ent = -1 - ent; const int tokr = SHARED ? ent : (ent >> 3); arow[m] = h2 + (size_t)tokr * 1024; }
        const bf16* Wgb = Wg + (size_t)(wn * 64 + 4 * fq) * 1024; const bf16* Wub = Wu + (size_t)(wn * 64 + 4 * fq) * 1024;
#pragma unroll 1
        for (int nq = 0; nq < 4; ++nq) {
            f32x4 acc[4][2];
            core_naive<2>([&](int m, int k8) { return *(const u32x4*)(arow[m] + 8 * k8); },
                          [&](int n, int r, int k8) { const bf16* base = (n == 0) ? Wgb : Wub; return *(const u32x4*)(base + (size_t)(16 * nq + r) * 1024 + 8 * k8); }, 1024, acc);
#pragma unroll
            for (int m = 0; m < 4; ++m) { const f32x4 g = acc[m][0], u = acc[m][1];
                st_elem4<32>(HT, wm * 64 + 16 * m + fr, wn * 64 + 16 * nq + 4 * fq, silu_f(g.x) * u.x, silu_f(g.y) * u.y, silu_f(g.z) * u.z, silu_f(g.w) * u.w); }
        }
    }
    __syncthreads();
#pragma unroll 1
    for (int nh = 0; nh < 8; ++nh) {
        f32x4 acc[4][2];
        const bf16* Wdb = Wd + (size_t)(nh * 128 + wn * 32 + 4 * fq) * 256;
        core_naive<2>([&](int m, int k8) { return ld_chunk<32>(HT, wm * 64 + 16 * m + fr, k8); },
                      [&](int n, int r, int k8) { return *(const u32x4*)(Wdb + (size_t)(16 * n + r) * 256 + 8 * k8); }, 256, acc);
#pragma unroll
        for (int m = 0; m < 4; ++m) {
            const int row = wm * 64 + 16 * m + fr; const int ent = sEnt[row];
            if (SHARED) {
                const int b = ent >> 13; float* xp = a.out + (size_t)ent * 1024 + nh * 128 + wn * 32 + 4 * fq; const float* gp = mod + b * 6144 + 5120 + nh * 128 + wn * 32 + 4 * fq;
#pragma unroll
                for (int n = 0; n < 2; ++n) { const f32x4 x1 = *(const f32x4*)(xp + 16 * n), gt = *(const f32x4*)(gp + 16 * n);
                    *(f32x4*)(xp + 16 * n) = x1 * DN_ALPHA + (gt + 1.0f) * acc[m][n]; }
            } else if (ent >= 0) {
                const float w = sW[row]; bf16* yp = Y + (size_t)ent * 1024 + nh * 128 + wn * 32 + 4 * fq;
#pragma unroll
                for (int n = 0; n < 2; ++n) { const f32x4 v = acc[m][n] * w; u32x2 o; o.x = pk2(v.x, v.y); o.y = pk2(v.z, v.w); *(u32x2*)(yp + 16 * n) = o; }
            }
        }
    }
}
__device__ __forceinline__ void phase_moe(const Args& a, LAS unsigned char* lds, int tid, int lane, int wave, int vcu, int G) {
    unsigned char* ws = a.ws;
    const unsigned* cnt = (const unsigned*)(ws + WS_CTL); const int* list = (const int*)(ws + WS_LIST); const float* topw = (const float*)(ws + WS_TOPW);
    LAS unsigned char* HT = lds;
    LAS int* pre = (LAS int*)(lds + 139264);
    LAS int* sEnt = (LAS int*)(lds + 139264 + 2048);
    LAS float* sW = (LAS float*)(lds + 139264 + 2048 + 512);
    if (tid == 0) { int s = 0; for (int e = 0; e < NE; ++e) { pre[e] = s; s += (int)((cnt[e] + 127u) >> 7); } pre[NE] = s; }
    __syncthreads();
    const int nrouted = pre[NE], nitems = nrouted + T / 128;
    for (int it = vcu; it < nitems; it += G) {
        __syncthreads();
        if (it >= nrouted) {
            if (tid < 128) { sEnt[tid] = (it - nrouted) * 128 + tid; sW[tid] = 1.f; }
            __syncthreads();
            moe_item<true>(a, HT, sEnt, sW, (const bf16*)(ws + WS_WSG), (const bf16*)(ws + WS_WSU), (const bf16*)(ws + WS_WSD), lane, wave);
        } else {
            int lo = 0, hi = NE - 1; while (lo < hi) { const int mid = (lo + hi + 1) >> 1; if (pre[mid] <= it) lo = mid; else hi = mid - 1; }
            const int e = lo, rb = it - pre[e];
            if (tid < 128) { const int n_e = (int)cnt[e], li = rb * 128 + tid; const bool valid = li < n_e; const int ent = list[(size_t)e * 32768 + (valid ? li : rb * 128)];
                sEnt[tid] = valid ? ent : -1 - ent; sW[tid] = valid ? topw[ent] : 0.f; }
            __syncthreads();
            moe_item<false>(a, HT, sEnt, sW, (const bf16*)(ws + WS_WEG) + (size_t)e * 262144, (const bf16*)(ws + WS_WEU) + (size_t)e * 262144, (const bf16*)(ws + WS_WED) + (size_t)e * 262144, lane, wave);
        }
    }
}

__device__ __forceinline__ void phase_final(const Args& a, int lane, int gw, int NGW) {
    const float* mod = (const float*)(a.ws + WS_MOD); const bf16* Y = (const bf16*)(a.ws + WS_Y);
    for (int row = gw; row < T; row += NGW) {
        const int b = row >> 13;
        f32x4* xr = (f32x4*)(a.out + (size_t)row * D) + lane;
        f32x4 v[4]; float s = 0.f;
#pragma unroll
        for (int j = 0; j < 4; ++j) { const int col = 4 * lane + 256 * j; f32x4 r = {0.f, 0.f, 0.f, 0.f};
#pragma unroll
            for (int k = 0; k < TOPK; ++k) { const u32x2 m = *((const u32x2*)(Y + ((size_t)row * 8 + k) * 1024) + lane + 64 * j);
                r += (f32x4){bf2f(m.x & 0xffffu), bf2f(m.x >> 16), bf2f(m.y & 0xffffu), bf2f(m.y >> 16)}; }
            const f32x4 gt = *(const f32x4*)(mod + b * 6144 + 5120 + col);
            v[j] = xr[64 * j] + (gt + 1.0f) * r; s += (v[j].x + v[j].y) + (v[j].z + v[j].w); }
        const float mean = wave_sum(s) * (1.f / D); float s2 = 0.f;
#pragma unroll
        for (int j = 0; j < 4; ++j) { v[j] = v[j] - mean; s2 += (v[j].x * v[j].x + v[j].y * v[j].y) + (v[j].z * v[j].z + v[j].w * v[j].w); }
        const float rstd = 1.f / sqrtf(wave_sum(s2) * (1.f / D) + LN_EPS);
#pragma unroll
        for (int j = 0; j < 4; ++j) { const int col = 4 * lane + 256 * j; xr[64 * j] = v[j] * rstd * *(const f32x4*)(a.in[29] + col) + *(const f32x4*)(a.in[30] + col); }
    }
}

template <int PH>
__global__ void __launch_bounds__(NTHREADS, 2) mk_fwd(Args a) {
    extern __shared__ __attribute__((aligned(16))) unsigned char lds_raw[];
    LAS unsigned char* lds = (LAS unsigned char*)lds_raw;
    const int tid = threadIdx.x, lane = tid & 63, wave = __builtin_amdgcn_readfirstlane(tid >> 6);
    const int G = gridDim.x, bx = blockIdx.x, vcu = (G % 8 == 0) ? (bx % 8) * (G / 8) + bx / 8 : bx;
    const int gw = vcu * NWAVES + wave, NGW = G * NWAVES;
    unsigned char* ws = a.ws;
    if constexpr (PH == 0) phase_prep(a, lds, tid, lane, wave, vcu, G);
    if constexpr (PH == 1) phase_ln1(a, lane, gw, NGW);
    if constexpr (PH == 2) { bf16* proj = (bf16*)(ws + WS_PROJ);
        phase_gemm_dense((const bf16*)(ws + WS_HB), (const bf16*)(ws + WS_WIN), T, 2048, 1024, lds, tid, lane, wave, vcu, G,
            [&](int row, int col, f32x4 v) { u32x2 o; o.x = pk2(v.x, v.y); o.y = pk2(v.z, v.w); *(u32x2*)(proj + (size_t)row * 2048 + col) = o; }); }
    if constexpr (PH == 3) phase_conv_gates(a, lane, gw, NGW);
    if constexpr (PH == 4) phase_mlstm_local(a, lds, tid, vcu, G);
    if constexpr (PH == 5) phase_scan(a, tid, vcu, G);
    if constexpr (PH == 6) phase_mixer_out(a, lds, tid, vcu, G);
    if constexpr (PH == 7) { bf16* mixo = (bf16*)(ws + WS_MIXO);
        phase_gemm_dense((const bf16*)(ws + WS_MIX), (const bf16*)(ws + WS_WOUT), T, 1024, 1024, lds, tid, lane, wave, vcu, G,
            [&](int row, int col, f32x4 v) { u32x2 o; o.x = pk2(v.x, v.y); o.y = pk2(v.z, v.w); *(u32x2*)(mixo + (size_t)row * 1024 + col) = o; }); }
    if constexpr (PH == 8) phase_ln2(a, lane, gw, NGW);
    if constexpr (PH == 9) { float* lg = (float*)(ws + WS_LOG);
        phase_gemm_dense((const bf16*)(ws + WS_H2), (const bf16*)(ws + WS_WR), T, 256, 1024, lds, tid, lane, wave, vcu, G,
            [&](int row, int col, f32x4 v) { *(f32x4*)(lg + (size_t)row * 256 + col) = v; }); }
    if constexpr (PH == 10) phase_route(a, lane, gw, NGW);
    if constexpr (PH == 11) phase_moe(a, lds, tid, lane, wave, vcu, G);
    if constexpr (PH == 12) phase_final(a, lane, gw, NGW);
}
template <int PH> static void launch_ph(int grid, hipStream_t stream, const Args& a) {
    static bool init = false;
    if (!init) { (void)hipFuncSetAttribute((const void*)mk_fwd<PH>, hipFuncAttributeMaxDynamicSharedMemorySize, LDS_BYTES); init = true; }
    hipLaunchKernelGGL(mk_fwd<PH>, dim3(grid), dim3(NTHREADS), LDS_BYTES, stream, a);
}

extern "C" void kernel_launch(void* const* d_in, const int* in_sizes, int n_in, void* d_out, int out_size, void* d_ws, size_t ws_size, hipStream_t stream) {
    static int grid = 0;
    if (grid == 0) {
        if (n_in != 31 || out_size != T * D || ws_size < WS_END) { fprintf(stderr, "kernel_launch: unexpected problem (n_in %d out %d ws %zu)\n", n_in, out_size, ws_size); grid = -1; return; }
        int dev = 0, cus = 0;
        if (hipGetDevice(&dev) != hipSuccess || hipDeviceGetAttribute(&cus, hipDeviceAttributeMultiprocessorCount, dev) != hipSuccess) { grid = -1; return; }
        grid = cus;
    }
    if (grid < 0) return;
    (void)hipMemsetAsync((char*)d_ws + WS_CTL, 0, CTL_BYTES, stream);
    Args a{};
    for (int i = 0; i < 31; ++i) a.in[i] = (const float*)d_in[i];
    a.out = (float*)d_out; a.ws = (unsigned char*)d_ws; a.ph_lo = 0; a.ph_hi = NPHASE;
    launch_ph<0>(grid, stream, a); launch_ph<1>(grid, stream, a); launch_ph<2>(grid, stream, a); launch_ph<3>(grid, stream, a);
    launch_ph<4>(grid, stream, a); launch_ph<5>(grid, stream, a); launch_ph<6>(grid, stream, a); launch_ph<7>(grid, stream, a);
    launch_ph<8>(grid, stream, a); launch_ph<9>(grid, stream, a); launch_ph<10>(grid, stream, a); launch_ph<11>(grid, stream, a);
    launch_ph<12>(grid, stream, a);
}
```

```cpp
#include <hip/hip_runtime.h>
#include <cstdio>
#include <cstdint>

#ifndef USE_MFMA
#define USE_MFMA 0
#endif

#ifndef ONLYPH
#define ONLYPH -1
#endif
#define PHEN(k) (ONLYPH < 0 || ONLYPH == (k))
#define LAS __attribute__((address_space(3)))
typedef unsigned short bf16;
typedef float f32x4 __attribute__((ext_vector_type(4)));
typedef short bf16x8 __attribute__((ext_vector_type(8)));
typedef unsigned u32x4 __attribute__((ext_vector_type(4)));
typedef unsigned u32x2 __attribute__((ext_vector_type(2)));

constexpr int NB = 4, SEQ = 8192, T = NB * SEQ, D = 1024;
constexpr int NH = 4, DH = 128, LCH = 128, NCH = SEQ / LCH;
constexpr int NE = 256, TOPK = 8, DE = 256;
constexpr float LN_EPS = 1e-5f, DN_ALPHA = 1.189207115002721f, ROUTE_SCALE = 2.5f, KSCALE = 0.08838834764831845f;
constexpr int NPHASE = 13;
constexpr int NTHREADS = 512, NWAVES = 8;
constexpr int LDS_BYTES = 147456;

constexpr size_t MiB = (size_t)1 << 20;
constexpr size_t WS_CTL = 0, CTL_BYTES = 1 * MiB;
constexpr size_t WS_MOD = 1 * MiB;
constexpr size_t WS_WG = 1 * MiB + 128 * 1024;
constexpr size_t WS_WIN = 2 * MiB;
constexpr size_t WS_WOUT = 6 * MiB;
constexpr size_t WS_WQKV = 8 * MiB;
constexpr size_t WS_WR = 9 * MiB;
constexpr size_t WS_WSP = 9 * MiB + 512 * 1024;
constexpr size_t WS_WSG = 10 * MiB;
constexpr size_t WS_WSU = 10 * MiB + 512 * 1024;
constexpr size_t WS_WSD = 11 * MiB;
constexpr size_t WS_WEG = 12 * MiB;
constexpr size_t WS_WEU = 140 * MiB;
constexpr size_t WS_WED = 268 * MiB;
constexpr size_t WS_H2 = 396 * MiB;
constexpr size_t WS_TOPI = 460 * MiB;
constexpr size_t WS_TOPW = 461 * MiB;
constexpr size_t WS_LIST = 462 * MiB;
constexpr size_t WS_LOG = 494 * MiB;
constexpr size_t WS_Y = 512 * MiB;
constexpr size_t WS_HB = 528 * MiB;
constexpr size_t WS_PROJ = 592 * MiB;
constexpr size_t WS_XC = 720 * MiB;
constexpr size_t WS_GATES = 752 * MiB;
constexpr size_t WS_QB = 754 * MiB;
constexpr size_t WS_CLOC = 786 * MiB;
constexpr size_t WS_NUML = 850 * MiB;
constexpr size_t WS_BCUM = 914 * MiB;
constexpr size_t WS_MLOC = 914 * MiB + 512 * 1024;
constexpr size_t WS_DEN = 915 * MiB;
constexpr size_t WS_GCH = 916 * MiB;
constexpr size_t WS_MLS = 916 * MiB + 4096;
constexpr size_t WS_MPREV = 916 * MiB + 8192;
constexpr size_t WS_NLOC = 916 * MiB + 512 * 1024;
constexpr size_t WS_NPREV = 917 * MiB;
constexpr size_t WS_CPREV = 918 * MiB;
constexpr size_t WS_MIX = 950 * MiB;
constexpr size_t WS_MIXO = WS_HB;
constexpr size_t WS_END = 1024 * MiB;

struct Args { const float* in[31]; float* out; unsigned char* ws; int ph_lo, ph_hi; };

__device__ __forceinline__ float bf2f(unsigned v) { return __uint_as_float(v << 16); }
__device__ __forceinline__ unsigned f2bf(float f) { unsigned u = __float_as_uint(f); return (u + 0x7fffu + ((u >> 16) & 1u)) >> 16; }
__device__ __forceinline__ unsigned pk2(float lo, float hi) { return f2bf(lo) | (f2bf(hi) << 16); }
__device__ __forceinline__ float rbf(float f) { return bf2f(f2bf(f)); }
__device__ __forceinline__ void unpack8(const u32x4 v, float (&o)[8]) {
    o[0] = __uint_as_float(v.x << 16); o[1] = __uint_as_float(v.x & 0xffff0000u);
    o[2] = __uint_as_float(v.y << 16); o[3] = __uint_as_float(v.y & 0xffff0000u);
    o[4] = __uint_as_float(v.z << 16); o[5] = __uint_as_float(v.z & 0xffff0000u);
    o[6] = __uint_as_float(v.w << 16); o[7] = __uint_as_float(v.w & 0xffff0000u);
}
__device__ __forceinline__ float wave_sum(float v) {
#pragma unroll
    for (int o = 1; o < 64; o <<= 1) v += __shfl_xor(v, o);
    return v;
}
__device__ __forceinline__ float wave_max(float v) {
#pragma unroll
    for (int o = 1; o < 64; o <<= 1) v = fmaxf(v, __shfl_xor(v, o));
    return v;
}
__device__ __forceinline__ float sigmoid_f(float x) { return 1.0f / (1.0f + __expf(-x)); }
__device__ __forceinline__ float silu_f(float x) { return x / (1.0f + __expf(-x)); }
__device__ __forceinline__ float gelu_f(float x) { return 0.5f * x * (1.0f + erff(x * 0.7071067811865476f)); }
__device__ __forceinline__ float logsigmoid_f(float x) { return fminf(x, 0.f) - log1pf(__expf(-fabsf(x))); }
#define LDS_WAIT() asm volatile("s_waitcnt lgkmcnt(0)" ::: "memory")

template <int CH> __device__ __forceinline__ int toff(int row, int chunk) {
    const int s = (CH == 4) ? ((row >> 1) & 3) : (CH == 8) ? (row & 7) : (row & 15);
    return row * (CH * 16) + ((chunk ^ s) << 4);
}
template <int CH> __device__ __forceinline__ u32x4 ld_chunk(const LAS unsigned char* tile, int row, int chunk) { return *(const LAS u32x4*)(tile + toff<CH>(row, chunk)); }
template <int CH> __device__ __forceinline__ void st_chunk(LAS unsigned char* tile, int row, int chunk, u32x4 v) { *(LAS u32x4*)(tile + toff<CH>(row, chunk)) = v; }
template <int CH> __device__ __forceinline__ float ld_elem(const LAS unsigned char* tile, int row, int col) { return bf2f(*(const LAS unsigned short*)(tile + toff<CH>(row, col >> 3) + (col & 7) * 2)); }
template <int CH> __device__ __forceinline__ void st_elem4(LAS unsigned char* tile, int row, int col  , float a, float b, float c, float d) {
    u32x2 v; v.x = pk2(a, b); v.y = pk2(c, d); *(LAS u32x2*)(tile + toff<CH>(row, col >> 3) + (col & 7) * 2) = v;
}
__device__ __forceinline__ float dot8(const float (&a)[8], const float (&b)[8], float acc) {
#pragma unroll
    for (int i = 0; i < 8; ++i) acc = fmaf(a[i], b[i], acc);
    return acc;
}

template <int NN, class FA, class FB>
__device__ __forceinline__ void core_naive(FA fa, FB fb, int K, f32x4 (&acc)[4][NN]) {
#pragma unroll
    for (int m = 0; m < 4; ++m)
#pragma unroll
        for (int n = 0; n < NN; ++n) acc[m][n] = (f32x4){0.f, 0.f, 0.f, 0.f};
    for (int k8 = 0; k8 < K / 8; ++k8) {
        float af[4][8];
#pragma unroll
        for (int m = 0; m < 4; ++m) unpack8(fa(m, k8), af[m]);
#pragma unroll
        for (int n = 0; n < NN; ++n)
#pragma unroll
            for (int r = 0; r < 4; ++r) {
                float bf[8]; unpack8(fb(n, r, k8), bf);
#pragma unroll
                for (int m = 0; m < 4; ++m) acc[m][n][r] = dot8(af[m], bf, acc[m][n][r]);
                asm volatile("" ::: "memory");
            }
    }
}

__device__ __forceinline__ void transpose_item(const float* W, int K, int N, bf16* WT, float scale, int item, int lane, LAS float* scr) {
    const int nblk = N / 32, kb = item / nblk, nb = item % nblk, k0 = 64 * kb, n0 = 32 * nb;
#pragma unroll 8
    for (int i = 0; i < 32; ++i) { const int kk = 2 * i + (lane >> 5); scr[kk * 33 + (lane & 31)] = W[(size_t)(k0 + kk) * N + n0 + (lane & 31)]; }
    LDS_WAIT();
    const int c = lane & 7;
#pragma unroll
    for (int j = 0; j < 4; ++j) {
        const int n = (lane >> 3) + 8 * j; const LAS float* s = scr + (8 * c) * 33 + n;
        u32x4 o; o.x = pk2(s[0 * 33] * scale, s[1 * 33] * scale); o.y = pk2(s[2 * 33] * scale, s[3 * 33] * scale);
        o.z = pk2(s[4 * 33] * scale, s[5 * 33] * scale); o.w = pk2(s[6 * 33] * scale, s[7 * 33] * scale);
        *(u32x4*)(WT + (size_t)(n0 + n) * K + k0 + 8 * c) = o;
    }
    LDS_WAIT();
}

__device__ __forceinline__ void phase_prep(const Args& a, LAS unsigned char* lds, int tid, int lane, int wave, int vcu, int G) {
    unsigned char* ws = a.ws;
    {
        LAS float* scr = (LAS float*)(lds + wave * 16384);
        const int gw = vcu * NWAVES + wave, NGW = G * NWAVES;
        constexpr int NITEMS = 1024 + 512 + 96 + 128 + 384 + 3 * 32768;
        for (int it = gw; it < NITEMS; it += NGW) {
            int r = it;
            if (r < 1024) { transpose_item(a.in[4], 1024, 2048, (bf16*)(ws + WS_WIN), 1.f, r, lane, scr); continue; } r -= 1024;
            if (r < 512) { transpose_item(a.in[18], 1024, 1024, (bf16*)(ws + WS_WOUT), 1.f, r, lane, scr); continue; } r -= 512;
            if (r < 96) { const int which = r / 32, rr = r % 32, h = rr / 8, ii = rr % 8;
                const float* src = (which == 0 ? a.in[7] : which == 1 ? a.in[8] : a.in[9]) + h * 16384;
                transpose_item(src, 128, 128, (bf16*)(ws + WS_WQKV) + (which * 4 + h) * 16384, which == 1 ? KSCALE : 1.f, ii, lane, scr); continue; } r -= 96;
            if (r < 128) { transpose_item(a.in[21], 1024, 256, (bf16*)(ws + WS_WR), 1.f, r, lane, scr); continue; } r -= 128;
            if (r < 128) { transpose_item(a.in[26], 1024, 256, (bf16*)(ws + WS_WSG), 1.f, r, lane, scr); continue; } r -= 128;
            if (r < 128) { transpose_item(a.in[27], 1024, 256, (bf16*)(ws + WS_WSU), 1.f, r, lane, scr); continue; } r -= 128;
            if (r < 128) { transpose_item(a.in[28], 256, 1024, (bf16*)(ws + WS_WSD), 1.f, r, lane, scr); continue; } r -= 128;
            if (r < 32768) { const int e = r >> 7; transpose_item(a.in[23] + (size_t)e * 262144, 1024, 256, (bf16*)(ws + WS_WEG) + (size_t)e * 262144, 1.f, r & 127, lane, scr); continue; } r -= 32768;
            if (r < 32768) { const int e = r >> 7; transpose_item(a.in[24] + (size_t)e * 262144, 1024, 256, (bf16*)(ws + WS_WEU) + (size_t)e * 262144, 1.f, r & 127, lane, scr); continue; } r -= 32768;
            { const int e = r >> 7; transpose_item(a.in[25] + (size_t)e * 262144, 256, 1024, (bf16*)(ws + WS_WED) + (size_t)e * 262144, 1.f, r & 127, lane, scr); }
        }
    }
    __syncthreads();
    {
        LAS float* sc = (LAS float*)lds;
        LAS float* part = (LAS float*)(lds + 16384);
        for (int it = vcu; it < 96; it += G) {
            __syncthreads();
            for (int i = tid; i < 4096; i += NTHREADS) sc[i] = silu_f(a.in[1][i]);
            __syncthreads();
            const int col = it * 64 + lane;
            float s0 = 0.f, s1 = 0.f, s2 = 0.f, s3 = 0.f;
            const float* wp = a.in[2] + (size_t)(wave * 128) * 6144 + col;
#pragma unroll 8
            for (int k = 0; k < 128; ++k) { const float w = wp[(size_t)k * 6144]; const int kk = wave * 128 + k;
                s0 = fmaf(sc[kk], w, s0); s1 = fmaf(sc[1024 + kk], w, s1); s2 = fmaf(sc[2048 + kk], w, s2); s3 = fmaf(sc[3072 + kk], w, s3); }
            part[(wave * 4 + 0) * 64 + lane] = s0; part[(wave * 4 + 1) * 64 + lane] = s1; part[(wave * 4 + 2) * 64 + lane] = s2; part[(wave * 4 + 3) * 64 + lane] = s3;
            __syncthreads();
            if (tid < 256) { const int b = tid >> 6, cl = tid & 63; float s = a.in[3][it * 64 + cl];
#pragma unroll
                for (int w = 0; w < 8; ++w) s += part[(w * 4 + b) * 64 + cl];
                ((float*)(ws + WS_MOD))[b * 6144 + it * 64 + cl] = s; }
        }
        __syncthreads();
    }
    {
        const int gt = vcu * NTHREADS + tid, NGT = G * NTHREADS;
        bf16* wsp = (bf16*)(ws + WS_WSP);
        for (int i = gt; i < 65536; i += NGT) { const int t = (i >> 7) & 127, s = i & 127; wsp[i] = (s <= t) ? (bf16)f2bf(a.in[16][i]) : (bf16)0; }
        float* wg = (float*)(ws + WS_WG);
        const float* wq = a.in[7]; const float* wk = a.in[8]; const float* wv = a.in[9]; const float* wif = a.in[10];
        for (int i = gt; i < 8192; i += NGT) {
            const int row = i >> 3, j = i & 7; float s = 0.f;
            if (row < 512) { const int h = row >> 7, d = row & 127; float sq = 0.f, sk = 0.f;
                for (int e = 0; e < 128; ++e) { sq = fmaf(wq[(h * 128 + d) * 128 + e], wif[(h * 128 + e) * 8 + j], sq); sk = fmaf(wk[(h * 128 + d) * 128 + e], wif[(512 + h * 128 + e) * 8 + j], sk); }
                s = sq + KSCALE * sk; }
            else { const int ch = row - 512, h = ch >> 7, d = ch & 127;
                for (int e = 0; e < 128; ++e) s = fmaf(wv[(h * 128 + d) * 128 + e], wif[(1024 + h * 128 + e) * 8 + j], s); }
            wg[i] = s;
        }
    }
}

__device__ __forceinline__ void phase_ln1(const Args& a, int lane, int gw, int NGW) {
    const float* mod = (const float*)(a.ws + WS_MOD); bf16* hb = (bf16*)(a.ws + WS_HB);
    for (int row = gw; row < T; row += NGW) {
        const int b = row >> 13;
        const f32x4* xr = (const f32x4*)(a.in[0] + (size_t)row * D) + lane;
        f32x4 v[4]; float s = 0.f;
#pragma unroll
        for (int j = 0; j < 4; ++j) { v[j] = xr[64 * j]; s += (v[j].x + v[j].y) + (v[j].z + v[j].w); }
        const float mean = wave_sum(s) * (1.f / D); float s2 = 0.f;
#pragma unroll
        for (int j = 0; j < 4; ++j) { v[j] = v[j] - mean; s2 += (v[j].x * v[j].x + v[j].y * v[j].y) + (v[j].z * v[j].z + v[j].w * v[j].w); }
        const float rstd = 1.f / sqrtf(wave_sum(s2) * (1.f / D) + LN_EPS);
        u32x2* o8 = (u32x2*)(hb + (size_t)row * D) + lane;
#pragma unroll
        for (int j = 0; j < 4; ++j) { const int col = 4 * lane + 256 * j;
            const f32x4 sh = *(const f32x4*)(mod + b * 6144 + col), sc = *(const f32x4*)(mod + b * 6144 + 1024 + col);
            const f32x4 h = v[j] * rstd * (sc + 1.0f) + sh; u32x2 w; w.x = pk2(h.x, h.y); w.y = pk2(h.z, h.w); o8[64 * j] = w; }
    }
}

template <class Epi>
__device__ __forceinline__ void phase_gemm_dense(const bf16* A, const bf16* Bt, int Mrows, int N, int K, LAS unsigned char* lds, int tid, int lane, int wave, int vcu, int G, Epi epi) {
    const int nM = Mrows / 256, nN = N / 256, wm = wave >> 1, wn = wave & 1, fr = lane & 15, fq = lane >> 4;
    for (int it = vcu; it < nM * nN; it += G) {
        const int pm = it / nN, pn = it % nN;
        const bf16* Ab = A + (size_t)(pm * 256 + wm * 64 + fr) * K;
        const bf16* Bb = Bt + (size_t)(pn * 256 + wn * 128 + 4 * fq) * K;
#pragma unroll 1
        for (int nq = 0; nq < 4; ++nq) {
            f32x4 acc[4][2];
            core_naive<2>([&](int m, int k8) { return *(const u32x4*)(Ab + (size_t)(16 * m) * K + 8 * k8); },
                          [&](int n, int r, int k8) { return *(const u32x4*)(Bb + (size_t)(16 * (2 * nq + n) + r) * K + 8 * k8); }, K, acc);
#pragma unroll
            for (int m = 0; m < 4; ++m)
#pragma unroll
                for (int n = 0; n < 2; ++n) epi(pm * 256 + wm * 64 + 16 * m + fr, pn * 256 + wn * 128 + 16 * (2 * nq + n) + 4 * fq, acc[m][n]);
        }
    }
}

__device__ __forceinline__ void phase_conv_gates(const Args& a, int lane, int gw, int NGW) {
    const bf16* proj = (const bf16*)(a.ws + WS_PROJ); bf16* xcb = (bf16*)(a.ws + WS_XC); float* gates = (float*)(a.ws + WS_GATES);
    const float* wg = (const float*)(a.ws + WS_WG); const float* cw = a.in[5]; const float* cb = a.in[6]; const float* bif = a.in[11];
    const int ch = lane * 8;
    for (int tok = gw; tok < T; tok += NGW) {
        const int ts = tok & (SEQ - 1);
        float acc[8], xm[8];
#pragma unroll
        for (int i = 0; i < 8; ++i) { acc[i] = cb[ch + i]; xm[i] = 0.f; }
#pragma unroll
        for (int j = 0; j < 4; ++j) {
            if (ts - 3 + j >= 0) {
                float v[8]; unpack8(*(const u32x4*)(proj + (size_t)(tok - 3 + j) * 2048 + ch), v);
#pragma unroll
                for (int i = 0; i < 8; ++i) { acc[i] = fmaf(cw[j * 512 + ch + i], v[i], acc[i]); if (j == 3) xm[i] = v[i]; }
            }
        }
        float xc[8];
#pragma unroll
        for (int i = 0; i < 8; ++i) xc[i] = rbf(silu_f(acc[i]));
        u32x4 o; o.x = pk2(xc[0], xc[1]); o.y = pk2(xc[2], xc[3]); o.z = pk2(xc[4], xc[5]); o.w = pk2(xc[6], xc[7]);
        *(u32x4*)(xcb + (size_t)tok * 512 + ch) = o;
        float g[8];
#pragma unroll
        for (int j = 0; j < 8; ++j) g[j] = 0.f;
#pragma unroll
        for (int i = 0; i < 8; ++i) {
            const f32x4 w1a = *(const f32x4*)(wg + (ch + i) * 8), w1b = *(const f32x4*)(wg + (ch + i) * 8 + 4);
            const f32x4 w2a = *(const f32x4*)(wg + (512 + ch + i) * 8), w2b = *(const f32x4*)(wg + (512 + ch + i) * 8 + 4);
            g[0] += xc[i] * w1a.x + xm[i] * w2a.x; g[1] += xc[i] * w1a.y + xm[i] * w2a.y; g[2] += xc[i] * w1a.z + xm[i] * w2a.z; g[3] += xc[i] * w1a.w + xm[i] * w2a.w;
            g[4] += xc[i] * w1b.x + xm[i] * w2b.x; g[5] += xc[i] * w1b.y + xm[i] * w2b.y; g[6] += xc[i] * w1b.z + xm[i] * w2b.z; g[7] += xc[i] * w1b.w + xm[i] * w2b.w;
        }
#pragma unroll
        for (int j = 0; j < 8; ++j) g[j] = wave_sum(g[j]);
        if (lane == 0) {
            f32x4 o0 = {g[0] + bif[0], g[1] + bif[1], g[2] + bif[2], g[3] + bif[3]}, o1 = {g[4] + bif[4], g[5] + bif[5], g[6] + bif[6], g[7] + bif[7]};
            *(f32x4*)(gates + (size_t)tok * 8) = o0; *(f32x4*)(gates + (size_t)tok * 8 + 4) = o1;
        }
    }
}

__device__ __forceinline__ void mm_nt_g(const LAS unsigned char* A, const bf16* Bg, int tid, float (&o)[32]) {
    const int t = tid >> 2, j0 = (tid & 3) * 32;
#pragma unroll
    for (int i = 0; i < 32; ++i) o[i] = 0.f;
    for (int c = 0; c < 16; ++c) {
        float af[8]; unpack8(ld_chunk<16>(A, t, c), af);
#pragma unroll
        for (int i = 0; i < 32; ++i) { float bf[8]; unpack8(*(const u32x4*)(Bg + (size_t)(j0 + i) * 128 + 8 * c), bf); o[i] = dot8(af, bf, o[i]); if ((i & 3) == 3) asm volatile("" ::: "memory"); }
    }
}
__device__ __forceinline__ void mm_nt_l(const LAS unsigned char* A, const LAS unsigned char* B, int tid, float (&o)[32]) {
    const int t = tid >> 2, j0 = (tid & 3) * 32;
#pragma unroll
    for (int i = 0; i < 32; ++i) o[i] = 0.f;
    for (int c = 0; c < 16; ++c) {
        float af[8]; unpack8(ld_chunk<16>(A, t, c), af);
#pragma unroll
        for (int i = 0; i < 32; ++i) { float bf[8]; unpack8(ld_chunk<16>(B, j0 + i, c), bf); o[i] = dot8(af, bf, o[i]); if ((i & 3) == 3) asm volatile("" ::: "memory"); }
    }
}
__device__ __forceinline__ void mm_nn_l(const LAS unsigned char* P, const LAS unsigned char* V, int tid, int slim, float (&o)[32]) {
    const int t = tid >> 2, c0 = (tid & 3) * 4;
#pragma unroll
    for (int i = 0; i < 32; ++i) o[i] = 0.f;
    for (int s = 0; s < slim; ++s) {
        const float p = ld_elem<16>(P, t, s);
#pragma unroll
        for (int cc = 0; cc < 4; ++cc) { float vf[8]; unpack8(ld_chunk<16>(V, s, c0 + cc), vf);
#pragma unroll
            for (int e = 0; e < 8; ++e) o[cc * 8 + e] = fmaf(p, vf[e], o[cc * 8 + e]); }
    }
}

__device__ __forceinline__ void phase_mlstm_local(const Args& a, LAS unsigned char* lds, int tid, int vcu, int G) {
    unsigned char* ws = a.ws;
    const bf16* proj = (const bf16*)(ws + WS_PROJ); const bf16* xcb = (const bf16*)(ws + WS_XC); const float* gates = (const float*)(ws + WS_GATES);
    bf16* qb = (bf16*)(ws + WS_QB); float* cloc = (float*)(ws + WS_CLOC); float* numl = (float*)(ws + WS_NUML);
    LAS unsigned char* TX = lds; LAS unsigned char* TQ = lds + 32768; LAS unsigned char* TK = lds + 65536; LAS unsigned char* TV = lds + 98304;
    LAS float* F = (LAS float*)(lds + 131072);
    LAS float* ipre = F; LAS float* bcum = F + 128; LAS float* wexp = F + 256; LAS float* uu = F + 384; LAS float* cm = F + 512; LAS float* misc = F + 640;
    const int t = tid >> 2, j0 = (tid & 3) * 32;
    for (int it = vcu; it < NB * NCH * NH; it += G) {
        const int h = it & 3, c = (it >> 2) & 63, b = it >> 8;
        const int t0 = b * SEQ + c * LCH; const int bhc = (b * NH + h) * NCH + c;
        __syncthreads();
        for (int i = tid; i < 2048; i += NTHREADS) { const int r = i >> 4, ch = i & 15; st_chunk<16>(TX, r, ch, *(const u32x4*)(xcb + (size_t)(t0 + r) * 512 + h * 128 + ch * 8)); }
        if (tid < 128) {
            const float ip = gates[(size_t)(t0 + tid) * 8 + h], fp = gates[(size_t)(t0 + tid) * 8 + 4 + h];
            ipre[tid] = ip; bcum[tid] = logsigmoid_f(fp);
        }
        __syncthreads();
        if (tid == 0) {
            float s = 0.f; for (int i = 0; i < 128; ++i) { s += bcum[i]; bcum[i] = s; }
            const float g = s; float mx = -3.0e38f, run = -3.0e38f;
            for (int i = 0; i < 128; ++i) { const float av = g - bcum[i] + ipre[i]; wexp[i] = av; mx = fmaxf(mx, av); const float u = ipre[i] - bcum[i]; uu[i] = u; run = fmaxf(run, u); cm[i] = run; }
            for (int i = 0; i < 128; ++i) wexp[i] = __expf(wexp[i] - mx);
            misc[0] = g; misc[1] = mx;
            ((float*)(ws + WS_GCH))[bhc] = g; ((float*)(ws + WS_MLS))[bhc] = mx;
        }
        float o[32];
        mm_nt_g(TX, (const bf16*)(ws + WS_WQKV) + (0 * 4 + h) * 16384, tid, o);
#pragma unroll
        for (int i = 0; i < 32; i += 4) st_elem4<16>(TQ, t, j0 + i, o[i], o[i + 1], o[i + 2], o[i + 3]);
#pragma unroll
        for (int i = 0; i < 32; i += 8) { u32x4 w; w.x = pk2(o[i], o[i + 1]); w.y = pk2(o[i + 2], o[i + 3]); w.z = pk2(o[i + 4], o[i + 5]); w.w = pk2(o[i + 6], o[i + 7]);
            *(u32x4*)(qb + (size_t)(t0 + t) * 512 + h * 128 + j0 + i) = w; }
        mm_nt_g(TX, (const bf16*)(ws + WS_WQKV) + (1 * 4 + h) * 16384, tid, o);
#pragma unroll
        for (int i = 0; i < 32; i += 4) st_elem4<16>(TK, t, j0 + i, o[i], o[i + 1], o[i + 2], o[i + 3]);
        __syncthreads();
        for (int i = tid; i < 2048; i += NTHREADS) { const int r = i >> 4, ch = i & 15; st_chunk<16>(TX, r, ch, *(const u32x4*)(proj + (size_t)(t0 + r) * 2048 + h * 128 + ch * 8)); }
        __syncthreads();
        mm_nt_g(TX, (const bf16*)(ws + WS_WQKV) + (2 * 4 + h) * 16384, tid, o);
#pragma unroll
        for (int i = 0; i < 32; i += 4) st_elem4<16>(TV, t, j0 + i, o[i], o[i + 1], o[i + 2], o[i + 3]);
        __syncthreads();
        {
#pragma unroll
            for (int i = 0; i < 32; ++i) o[i] = 0.f;
            for (int l = 0; l < 128; ++l) {
                const float vv = ld_elem<16>(TV, l, t) * wexp[l];
#pragma unroll
                for (int cc = 0; cc < 4; ++cc) { float kf[8]; unpack8(ld_chunk<16>(TK, l, (tid & 3) * 4 + cc), kf);
#pragma unroll
                    for (int e = 0; e < 8; ++e) o[cc * 8 + e] = fmaf(vv, kf[e], o[cc * 8 + e]); }
            }
            float* cp = cloc + (size_t)bhc * 16384 + t * 128 + j0;
#pragma unroll
            for (int i = 0; i < 32; i += 4) *(f32x4*)(cp + i) = (f32x4){o[i], o[i + 1], o[i + 2], o[i + 3]};
            if (tid < 128) { float s = 0.f; for (int l = 0; l < 128; ++l) s = fmaf(wexp[l], ld_elem<16>(TK, l, tid), s); ((float*)(ws + WS_NLOC))[(size_t)bhc * 128 + tid] = s; }
        }
        mm_nt_l(TQ, TK, tid, o);
        float den = 0.f;
        {
            const float cmt = cm[t];
#pragma unroll
            for (int i = 0; i < 32; ++i) { const int s = j0 + i; float p = (s <= t) ? __expf(uu[s] - cmt) * o[i] : 0.f; p = rbf(p); o[i] = p; den += p; }
            den += __shfl_xor(den, 1); den += __shfl_xor(den, 2);
        }
        __syncthreads();
#pragma unroll
        for (int i = 0; i < 32; i += 4) st_elem4<16>(TX, t, j0 + i, o[i], o[i + 1], o[i + 2], o[i + 3]);
        __syncthreads();
        mm_nn_l(TX, TV, tid, 128, o);
        {
            float* np = numl + (size_t)(t0 + t) * 512 + h * 128 + j0;
#pragma unroll
            for (int i = 0; i < 32; i += 4) *(f32x4*)(np + i) = (f32x4){o[i], o[i + 1], o[i + 2], o[i + 3]};
            if ((tid & 3) == 0) {
                ((float*)(ws + WS_BCUM))[(size_t)(t0 + t) * 4 + h] = bcum[t];
                ((float*)(ws + WS_MLOC))[(size_t)(t0 + t) * 4 + h] = bcum[t] + cm[t];
                ((float*)(ws + WS_DEN))[(size_t)(t0 + t) * 4 + h] = den;
            }
        }
    }
}

__device__ __forceinline__ void phase_scan(const Args& a, int tid, int vcu, int G) {
    unsigned char* ws = a.ws;
    const float* gch = (const float*)(ws + WS_GCH); const float* mls = (const float*)(ws + WS_MLS);
    const float* cloc = (const float*)(ws + WS_CLOC); bf16* cprev = (bf16*)(ws + WS_CPREV);
    const float* nloc = (const float*)(ws + WS_NLOC); float* nprev = (float*)(ws + WS_NPREV); float* mprev = (float*)(ws + WS_MPREV);
    for (int it = vcu; it < 512 + 4; it += G) {
        if (it < 512) {
            const int bh = it >> 5, e = (it & 31) * 512 + tid;
            float m = 0.f, C = 0.f;
            for (int c = 0; c < NCH; ++c) {
                const size_t idx = (size_t)(bh * NCH + c) * 16384 + e;
                cprev[idx] = (bf16)f2bf(C);
                const float g = gch[bh * NCH + c], ml = mls[bh * NCH + c], mn = fmaxf(g + m, ml);
                C = __expf(g + m - mn) * C + __expf(ml - mn) * cloc[idx]; m = mn;
            }
        } else {
            const int gi = (it - 512) * 512 + tid, bh = gi >> 7, e = gi & 127;
            float m = 0.f, n = 0.f;
            for (int c = 0; c < NCH; ++c) {
                const size_t idx = (size_t)(bh * NCH + c) * 128 + e;
                nprev[idx] = n; if (e == 0) mprev[bh * NCH + c] = m;
                const float g = gch[bh * NCH + c], ml = mls[bh * NCH + c], mn = fmaxf(g + m, ml);
                n = __expf(g + m - mn) * n + __expf(ml - mn) * nloc[idx]; m = mn;
            }
        }
    }
}

__device__ __forceinline__ void phase_mixer_out(const Args& a, LAS unsigned char* lds, int tid, int vcu, int G) {
    unsigned char* ws = a.ws;
    const bf16* proj = (const bf16*)(ws + WS_PROJ); const bf16* xcb = (const bf16*)(ws + WS_XC); const bf16* qb = (const bf16*)(ws + WS_QB);
    const bf16* cprev = (const bf16*)(ws + WS_CPREV); const float* numl = (const float*)(ws + WS_NUML); bf16* mix = (bf16*)(ws + WS_MIX);
    LAS unsigned char* TQ = lds; LAS unsigned char* TC = lds + 32768; LAS unsigned char* TV = lds + 65536;
    const int t = tid >> 2, j0 = (tid & 3) * 32;
    for (int it = vcu; it < NB * NCH * NH; it += G) {
        const int h = it & 3, c = (it >> 2) & 63, b = it >> 8;
        const int t0 = b * SEQ + c * LCH; const int bhc = (b * NH + h) * NCH + c; const int tok = t0 + t;
        __syncthreads();
        for (int i = tid; i < 2048; i += NTHREADS) { const int r = i >> 4, ch = i & 15;
            st_chunk<16>(TQ, r, ch, *(const u32x4*)(qb + (size_t)(t0 + r) * 512 + h * 128 + ch * 8));
            st_chunk<16>(TC, r, ch, *(const u32x4*)(cprev + (size_t)bhc * 16384 + r * 128 + ch * 8)); }
        {
            float vg[32]; float s = 0.f;
#pragma unroll
            for (int i = 0; i < 32; i += 8) { float vf[8];
                unpack8(*(const u32x4*)(proj + (size_t)tok * 2048 + 1536 + h * 128 + j0 + i), vf);
#pragma unroll
                for (int e = 0; e < 8; ++e) { vg[i + e] = gelu_f(vf[e]); s += vg[i + e]; } }
            s += __shfl_xor(s, 1); s += __shfl_xor(s, 2);
            const float mean = s * (1.f / 128.f); float q = 0.f;
#pragma unroll
            for (int i = 0; i < 32; ++i) { vg[i] -= mean; q += vg[i] * vg[i]; }
            q += __shfl_xor(q, 1); q += __shfl_xor(q, 2);
            const float rstd = 1.f / sqrtf(q * (1.f / 128.f) + LN_EPS);
#pragma unroll
            for (int i = 0; i < 32; ++i) vg[i] = vg[i] * rstd * a.in[14][h * 128 + j0 + i] + a.in[15][h * 128 + j0 + i];
#pragma unroll
            for (int i = 0; i < 32; i += 4) st_elem4<16>(TV, t, j0 + i, vg[i], vg[i + 1], vg[i + 2], vg[i + 3]);
        }
        __syncthreads();
        float o[32];
        mm_nt_l(TQ, TC, tid, o);
        {
            float nqi = 0.f;
            const float* np = (const float*)(ws + WS_NPREV) + (size_t)bhc * 128;
#pragma unroll
            for (int i = 0; i < 32; ++i) nqi = fmaf(ld_elem<16>(TQ, t, j0 + i), np[j0 + i], nqi);
            nqi += __shfl_xor(nqi, 1); nqi += __shfl_xor(nqi, 2);
            const float mp = ((const float*)(ws + WS_MPREV))[bhc];
            const float bc = ((const float*)(ws + WS_BCUM))[(size_t)tok * 4 + h], ml = ((const float*)(ws + WS_MLOC))[(size_t)tok * 4 + h], den = ((const float*)(ws + WS_DEN))[(size_t)tok * 4 + h];
            const float mt = fmaxf(bc + mp, ml), wi = __expf(bc + mp - mt), wl = __expf(ml - mt);
            const float nq = wi * nqi + wl * den, dn = 1.f / fmaxf(fabsf(nq), __expf(-mt));
            const float* nlp = numl + (size_t)tok * 512 + h * 128 + j0;
            float s = 0.f;
#pragma unroll
            for (int i = 0; i < 32; ++i) { o[i] = (wi * o[i] + wl * nlp[i]) * dn; s += o[i]; }
            s += __shfl_xor(s, 1); s += __shfl_xor(s, 2);
            const float mean = s * (1.f / 128.f); float q = 0.f;
#pragma unroll
            for (int i = 0; i < 32; ++i) { o[i] -= mean; q += o[i] * o[i]; }
            q += __shfl_xor(q, 1); q += __shfl_xor(q, 2);
            const float rstd = 1.f / sqrtf(q * (1.f / 128.f) + LN_EPS);
#pragma unroll
            for (int i = 0; i < 32; i += 8) {
                float zf[8], xf[8], r[8];
                unpack8(*(const u32x4*)(proj + (size_t)tok * 2048 + 512 + h * 128 + j0 + i), zf); unpack8(*(const u32x4*)(xcb + (size_t)tok * 512 + h * 128 + j0 + i), xf);
#pragma unroll
                for (int e = 0; e < 8; ++e) { const int ch = h * 128 + j0 + i + e; const float hc = o[i + e] * rstd * a.in[12][ch]; r[e] = sigmoid_f(zf[e]) * (hc + a.in[13][ch] * xf[e]); }
                u32x4 w; w.x = pk2(r[0], r[1]); w.y = pk2(r[2], r[3]); w.z = pk2(r[4], r[5]); w.w = pk2(r[6], r[7]);
                *(u32x4*)(mix + (size_t)tok * 1024 + h * 128 + j0 + i) = w;
            }
        }
        {
            const bf16* wrow = (const bf16*)(ws + WS_WSP) + (size_t)h * 16384 + t * 128;
#pragma unroll
            for (int i = 0; i < 32; ++i) o[i] = 0.f;
            for (int s = 0; s <= t; ++s) {
                const float p = bf2f(wrow[s]);
#pragma unroll
                for (int cc = 0; cc < 4; ++cc) { float vf[8]; unpack8(ld_chunk<16>(TV, s, (tid & 3) * 4 + cc), vf);
#pragma unroll
                    for (int e = 0; e < 8; ++e) o[cc * 8 + e] = fmaf(p, vf[e], o[cc * 8 + e]); }
            }
            const float bsp = a.in[17][h * 128 + t];
#pragma unroll
            for (int i = 0; i < 32; i += 8) { u32x4 w; float ug[8];
                unpack8(*(const u32x4*)(proj + (size_t)tok * 2048 + 1024 + h * 128 + j0 + i), ug);
#pragma unroll
                for (int e = 0; e < 8; ++e) ug[e] = gelu_f(ug[e]);
                w.x = pk2(ug[0] * (o[i] + bsp), ug[1] * (o[i + 1] + bsp)); w.y = pk2(ug[2] * (o[i + 2] + bsp), ug[3] * (o[i + 3] + bsp));
                w.z = pk2(ug[4] * (o[i + 4] + bsp), ug[5] * (o[i + 5] + bsp)); w.w = pk2(ug[6] * (o[i + 6] + bsp), ug[7] * (o[i + 7] + bsp));
                *(u32x4*)(mix + (size_t)tok * 1024 + 512 + h * 128 + j0 + i) = w; }
        }
    }
}

__device__ __forceinline__ void phase_ln2(const Args& a, int lane, int gw, int NGW) {
    const float* mod = (const float*)(a.ws + WS_MOD); const bf16* mixo = (const bf16*)(a.ws + WS_MIXO); bf16* h2 = (bf16*)(a.ws + WS_H2);
    for (int row = gw; row < T; row += NGW) {
        const int b = row >> 13;
        const f32x4* xr = (const f32x4*)(a.in[0] + (size_t)row * D) + lane; const u32x2* mr = (const u32x2*)(mixo + (size_t)row * D) + lane;
        f32x4 v[4]; float s = 0.f;
#pragma unroll
        for (int j = 0; j < 4; ++j) { const int col = 4 * lane + 256 * j; const f32x4 x = xr[64 * j]; const u32x2 m = mr[64 * j];
            const f32x4 gt = *(const f32x4*)(mod + b * 6144 + 2048 + col);
            const f32x4 mv = {bf2f(m.x & 0xffffu), bf2f(m.x >> 16), bf2f(m.y & 0xffffu), bf2f(m.y >> 16)};
            v[j] = x * DN_ALPHA + (gt + 1.0f) * mv; s += (v[j].x + v[j].y) + (v[j].z + v[j].w); }
        float mean = wave_sum(s) * (1.f / D), s2 = 0.f;
#pragma unroll
        for (int j = 0; j < 4; ++j) { v[j] = v[j] - mean; s2 += (v[j].x * v[j].x + v[j].y * v[j].y) + (v[j].z * v[j].z + v[j].w * v[j].w); }
        float rstd = 1.f / sqrtf(wave_sum(s2) * (1.f / D) + LN_EPS);
        f32x4* xo = (f32x4*)(a.out + (size_t)row * D) + lane; s = 0.f;
#pragma unroll
        for (int j = 0; j < 4; ++j) { const int col = 4 * lane + 256 * j;
            v[j] = v[j] * rstd * *(const f32x4*)(a.in[19] + col) + *(const f32x4*)(a.in[20] + col); xo[64 * j] = v[j]; s += (v[j].x + v[j].y) + (v[j].z + v[j].w); }
        mean = wave_sum(s) * (1.f / D); s2 = 0.f;
#pragma unroll
        for (int j = 0; j < 4; ++j) { v[j] = v[j] - mean; s2 += (v[j].x * v[j].x + v[j].y * v[j].y) + (v[j].z * v[j].z + v[j].w * v[j].w); }
        rstd = 1.f / sqrtf(wave_sum(s2) * (1.f / D) + LN_EPS);
        u32x2* o8 = (u32x2*)(h2 + (size_t)row * D) + lane;
#pragma unroll
        for (int j = 0; j < 4; ++j) { const int col = 4 * lane + 256 * j;
            const f32x4 sh = *(const f32x4*)(mod + b * 6144 + 3072 + col), sc = *(const f32x4*)(mod + b * 6144 + 4096 + col);
            const f32x4 h = v[j] * rstd * (sc + 1.0f) + sh; u32x2 w; w.x = pk2(h.x, h.y); w.y = pk2(h.z, h.w); o8[64 * j] = w; }
    }
}

__device__ __forceinline__ void phase_route(const Args& a, int lane, int gw, int NGW) {
    unsigned char* ws = a.ws;
    const float* logits = (const float*)(ws + WS_LOG); const float* ebias = a.in[22];
    unsigned* cnt = (unsigned*)(ws + WS_CTL); int* topi = (int*)(ws + WS_TOPI); float* topw = (float*)(ws + WS_TOPW); int* list = (int*)(ws + WS_LIST);
    const f32x4 eb = *(const f32x4*)(ebias + lane * 4);
    for (int tok = gw; tok < T; tok += NGW) {
        const f32x4 lg = *(const f32x4*)(logits + (size_t)tok * 256 + lane * 4);
        float sc[4] = {sigmoid_f(lg.x), sigmoid_f(lg.y), sigmoid_f(lg.z), sigmoid_f(lg.w)};
        float sel[4] = {sc[0] + eb.x, sc[1] + eb.y, sc[2] + eb.z, sc[3] + eb.w};
        float m1 = fmaxf(sel[0], sel[1]), m2 = fminf(sel[0], sel[1]);
        { const float c = sel[2]; if (c > m1) { m2 = m1; m1 = c; } else if (c > m2) m2 = c; }
        { const float c = sel[3]; if (c > m1) { m2 = m1; m1 = c; } else if (c > m2) m2 = c; }
#pragma unroll
        for (int o = 1; o < 8; o <<= 1) { const float b1 = __shfl_xor(m1, o), b2 = __shfl_xor(m2, o); const float n1 = fmaxf(m1, b1), n2 = fmaxf(fminf(m1, b1), fmaxf(m2, b2)); m1 = n1; m2 = n2; }
        const float gs = m1 + m2; const int mygrp = lane >> 3; int rank = 0;
#pragma unroll
        for (int g = 0; g < 8; ++g) { const float og = __shfl(gs, g * 8); rank += (og > gs || (og == gs && g < mygrp)) ? 1 : 0; }
        const bool allowed = rank < 4;
#pragma unroll
        for (int i = 0; i < 4; ++i) if (!allowed) sel[i] = -INFINITY;
        int myE = 0; float myS = 0.f, ssum = 0.f;
#pragma unroll 1
        for (int k = 0; k < TOPK; ++k) {
            float bv = sel[0]; int bi = lane * 4;
            if (sel[1] > bv) { bv = sel[1]; bi = lane * 4 + 1; }
            if (sel[2] > bv) { bv = sel[2]; bi = lane * 4 + 2; }
            if (sel[3] > bv) { bv = sel[3]; bi = lane * 4 + 3; }
#pragma unroll
            for (int o = 1; o < 64; o <<= 1) { const float ov = __shfl_xor(bv, o); const int oi = __shfl_xor(bi, o); if (ov > bv || (ov == bv && oi < bi)) { bv = ov; bi = oi; } }
            const int sub = bi & 3; const float mysc = sub == 0 ? sc[0] : sub == 1 ? sc[1] : sub == 2 ? sc[2] : sc[3];
            const float wsc = __shfl(mysc, bi >> 2);
            if ((bi >> 2) == lane) { if (sub == 0) sel[0] = -INFINITY; else if (sub == 1) sel[1] = -INFINITY; else if (sub == 2) sel[2] = -INFINITY; else sel[3] = -INFINITY; }
            if (lane == k) { myE = bi; myS = wsc; }
            ssum += wsc;
        }
        if (lane < TOPK) {
            const float w = myS / ssum * ROUTE_SCALE;
            topi[(size_t)tok * 8 + lane] = myE; topw[(size_t)tok * 8 + lane] = w;
            const unsigned pos = atomicAdd(&cnt[myE], 1u);
            list[(size_t)myE * 32768 + pos] = tok * 8 + lane;
        }
    }
}

template <bool SHARED>
__device__ __forceinline__ void moe_item(const Args& a, LAS unsigned char* HT, const LAS int* sEnt, const LAS float* sW, const bf16* Wg, const bf16* Wu, const bf16* Wd, int lane, int wave) {
    unsigned char* ws = a.ws;
    const bf16* h2 = (const bf16*)(ws + WS_H2); bf16* Y = (bf16*)(ws + WS_Y); const float* mod = (const float*)(ws + WS_MOD);
    const int wm = wave >> 2, wn = wave & 3, fr = lane & 15, fq = lane >> 4;
    {
        const bf16* arow[4];
#pragma unroll
        for (int m = 0; m < 4; ++m) { int ent = sEnt[wm * 64 + 16 * m + fr]; if (ent < 0) ent = -1 - ent; const int tokr = SHARED ? ent : (ent >> 3); arow[m] = h2 + (size_t)tokr * 1024; }
        const bf16* Wgb = Wg + (size_t)(wn * 64 + 4 * fq) * 1024; const bf16* Wub = Wu + (size_t)(wn * 64 + 4 * fq) * 1024;
#pragma unroll 1
        for (int nq = 0; nq < 4; ++nq) {
            f32x4 acc[4][2];
            core_naive<2>([&](int m, int k8) { return *(const u32x4*)(arow[m] + 8 * k8); },
                          [&](int n, int r, int k8) { const bf16* base = (n == 0) ? Wgb : Wub; return *(const u32x4*)(base + (size_t)(16 * nq + r) * 1024 + 8 * k8); }, 1024, acc);
#pragma unroll
            for (int m = 0; m < 4; ++m) { const f32x4 g = acc[m][0], u = acc[m][1];
                st_elem4<32>(HT, wm * 64 + 16 * m + fr, wn * 64 + 16 * nq + 4 * fq, silu_f(g.x) * u.x, silu_f(g.y) * u.y, silu_f(g.z) * u.z, silu_f(g.w) * u.w); }
        }
    }
    __syncthreads();
#pragma unroll 1
    for (int nh = 0; nh < 8; ++nh) {
        f32x4 acc[4][2];
        const bf16* Wdb = Wd + (size_t)(nh * 128 + wn * 32 + 4 * fq) * 256;
        core_naive<2>([&](int m, int k8) { return ld_chunk<32>(HT, wm * 64 + 16 * m + fr, k8); },
                      [&](int n, int r, int k8) { return *(const u32x4*)(Wdb + (size_t)(16 * n + r) * 256 + 8 * k8); }, 256, acc);
#pragma unroll
        for (int m = 0; m < 4; ++m) {
            const int row = wm * 64 + 16 * m + fr; const int ent = sEnt[row];
            if (SHARED) {
                const int b = ent >> 13; float* xp = a.out + (size_t)ent * 1024 + nh * 128 + wn * 32 + 4 * fq; const float* gp = mod + b * 6144 + 5120 + nh * 128 + wn * 32 + 4 * fq;
#pragma unroll
                for (int n = 0; n < 2; ++n) { const f32x4 x1 = *(const f32x4*)(xp + 16 * n), gt = *(const f32x4*)(gp + 16 * n);
                    *(f32x4*)(xp + 16 * n) = x1 * DN_ALPHA + (gt + 1.0f) * acc[m][n]; }
            } else if (ent >= 0) {
                const float w = sW[row]; bf16* yp = Y + (size_t)ent * 1024 + nh * 128 + wn * 32 + 4 * fq;
#pragma unroll
                for (int n = 0; n < 2; ++n) { const f32x4 v = acc[m][n] * w; u32x2 o; o.x = pk2(v.x, v.y); o.y = pk2(v.z, v.w); *(u32x2*)(yp + 16 * n) = o; }
            }
        }
    }
}
__device__ __forceinline__ void phase_moe(const Args& a, LAS unsigned char* lds, int tid, int lane, int wave, int vcu, int G) {
    unsigned char* ws = a.ws;
    const unsigned* cnt = (const unsigned*)(ws + WS_CTL); const int* list = (const int*)(ws + WS_LIST); const float* topw = (const float*)(ws + WS_TOPW);
    LAS unsigned char* HT = lds;
    LAS int* pre = (LAS int*)(lds + 139264);
    LAS int* sEnt = (LAS int*)(lds + 139264 + 2048);
    LAS float* sW = (LAS float*)(lds + 139264 + 2048 + 512);
    if (tid == 0) { int s = 0; for (int e = 0; e < NE; ++e) { pre[e] = s; s += (int)((cnt[e] + 127u) >> 7); } pre[NE] = s; }
    __syncthreads();
    const int nrouted = pre[NE], nitems = nrouted + T / 128;
    for (int it = vcu; it < nitems; it += G) {
        __syncthreads();
        if (it >= nrouted) {
            if (tid < 128) { sEnt[tid] = (it - nrouted) * 128 + tid; sW[tid] = 1.f; }
            __syncthreads();
            moe_item<true>(a, HT, sEnt, sW, (const bf16*)(ws + WS_WSG), (const bf16*)(ws + WS_WSU), (const bf16*)(ws + WS_WSD), lane, wave);
        } else {
            int lo = 0, hi = NE - 1; while (lo < hi) { const int mid = (lo + hi + 1) >> 1; if (pre[mid] <= it) lo = mid; else hi = mid - 1; }
            const int e = lo, rb = it - pre[e];
            if (tid < 128) { const int n_e = (int)cnt[e], li = rb * 128 + tid; const bool valid = li < n_e; const int ent = list[(size_t)e * 32768 + (valid ? li : rb * 128)];
                sEnt[tid] = valid ? ent : -1 - ent; sW[tid] = valid ? topw[ent] : 0.f; }
            __syncthreads();
            moe_item<false>(a, HT, sEnt, sW, (const bf16*)(ws + WS_WEG) + (size_t)e * 262144, (const bf16*)(ws + WS_WEU) + (size_t)e * 262144, (const bf16*)(ws + WS_WED) + (size_t)e * 262144, lane, wave);
        }
    }
}

__device__ __forceinline__ void phase_final(const Args& a, int lane, int gw, int NGW) {
    const float* mod = (const float*)(a.ws + WS_MOD); const bf16* Y = (const bf16*)(a.ws + WS_Y);
    for (int row = gw; row < T; row += NGW) {
        const int b = row >> 13;
        f32x4* xr = (f32x4*)(a.out + (size_t)row * D) + lane;
        f32x4 v[4]; float s = 0.f;
#pragma unroll
        for (int j = 0; j < 4; ++j) { const int col = 4 * lane + 256 * j; f32x4 r = {0.f, 0.f, 0.f, 0.f};
#pragma unroll
            for (int k = 0; k < TOPK; ++k) { const u32x2 m = *((const u32x2*)(Y + ((size_t)row * 8 + k) * 1024) + lane + 64 * j);
                r += (f32x4){bf2f(m.x & 0xffffu), bf2f(m.x >> 16), bf2f(m.y & 0xffffu), bf2f(m.y >> 16)}; }
            const f32x4 gt = *(const f32x4*)(mod + b * 6144 + 5120 + col);
            v[j] = xr[64 * j] + (gt + 1.0f) * r; s += (v[j].x + v[j].y) + (v[j].z + v[j].w); }
        const float mean = wave_sum(s) * (1.f / D); float s2 = 0.f;
#pragma unroll
        for (int j = 0; j < 4; ++j) { v[j] = v[j] - mean; s2 += (v[j].x * v[j].x + v[j].y * v[j].y) + (v[j].z * v[j].z + v[j].w * v[j].w); }
        const float rstd = 1.f / sqrtf(wave_sum(s2) * (1.f / D) + LN_EPS);
#pragma unroll
        for (int j = 0; j < 4; ++j) { const int col = 4 * lane + 256 * j; xr[64 * j] = v[j] * rstd * *(const f32x4*)(a.in[29] + col) + *(const f32x4*)(a.in[30] + col); }
    }
}

#define XB_TMO      128
#define XB_XCNT(j)  (256  + 64 * (j))
#define XB_XSUB(j)  (1280 + 64 * (j))
#define XB_XGEN(j)  (2304 + 64 * (j))
#define XB_TOP      3328
#define XB_TOPGEN   3392
#define XCD_BAR_WORDS 3456
#define XB_SPIN_CAP (1u << 20)
constexpr int CW_BAR = 4096;
__device__ __forceinline__ unsigned xb_ld(unsigned* p)              { return __hip_atomic_load(p, __ATOMIC_RELAXED, __HIP_MEMORY_SCOPE_AGENT); }
__device__ __forceinline__ unsigned xb_add(unsigned* p, unsigned v) { return __hip_atomic_fetch_add(p, v, __ATOMIC_RELAXED, __HIP_MEMORY_SCOPE_AGENT); }
__device__ __forceinline__ unsigned xb_xcc_id() { return (unsigned)__builtin_amdgcn_s_getreg((3 << 11) | 20) & 0xFu; }
#define XB_SPIN(cond, bar) do { unsigned _sp = 0; while (cond) { __builtin_amdgcn_s_sleep(1); \
    if ((++_sp & 255u) == 0u) { if (xb_ld(&(bar)[XB_TMO])) break; if (_sp > XB_SPIN_CAP) { atomicAdd(&(bar)[XB_TMO], 1u); break; } } } } while (0)
struct XcdBarrier { unsigned* bar; unsigned x; volatile LAS unsigned* st; };
__device__ __forceinline__ XcdBarrier xcd_barrier_post(unsigned* bar, volatile LAS unsigned* st) {
    XcdBarrier b; b.bar = bar; b.x = xb_xcc_id(); b.st = st;
    if (threadIdx.x == 0) (void)xb_add(&bar[XB_XCNT(b.x)], 1u);
    return b;
}
__device__ __forceinline__ void xcd_barrier_complete(unsigned* bar, unsigned x, unsigned& nloc, unsigned& nx) {
    const unsigned G = gridDim.x * gridDim.y * gridDim.z;
    unsigned sum, cnt, mine, sp = 0u;
    for (;;) {
        sum = 0u; cnt = 0u; mine = 0u;
#pragma unroll
        for (unsigned j = 0; j < 16; ++j) { const unsigned c = xb_ld(&bar[XB_XCNT(j)]); sum += c; cnt += (c > 0u) ? 1u : 0u; mine = (j == x) ? c : mine; }
        if (sum == G) break;
        __builtin_amdgcn_s_sleep(1);
        if ((++sp & 255u) == 0u) { if (xb_ld(&bar[XB_TMO])) break; if (sp > XB_SPIN_CAP) { atomicAdd(&bar[XB_TMO], 1u); break; } }
    }
    nloc = mine > 0u ? mine : 1u; nx = cnt > 0u ? cnt : 1u;
}
__device__ __forceinline__ void xcd_barrier(const XcdBarrier& b) {
    asm volatile("s_waitcnt vmcnt(0)" ::: "memory");
    __syncthreads();
    if (threadIdx.x == 0) {
        unsigned* bar = b.bar;
        __builtin_amdgcn_s_waitcnt(0);
        unsigned nloc = b.st[0], nx = b.st[1];
        if (nloc == 0u) { xcd_barrier_complete(bar, b.x, nloc, nx); b.st[0] = nloc; b.st[1] = nx; }
        const unsigned old = xb_add(&bar[XB_XSUB(b.x)], 1u);
        const unsigned gen = old / nloc;
        if (old + 1u == (gen + 1u) * nloc) {
            __builtin_amdgcn_fence(__ATOMIC_RELEASE, "agent");
            asm volatile("s_waitcnt vmcnt(0)" ::: "memory");
            const unsigned og = xb_add(&bar[XB_TOP], 1u);
            const unsigned tg = og / nx;
            if (og + 1u == (tg + 1u) * nx) xb_add(&bar[XB_TOPGEN], 1u);
            else XB_SPIN(xb_ld(&bar[XB_TOPGEN]) == tg, bar);
            __builtin_amdgcn_fence(__ATOMIC_ACQUIRE, "agent");
            xb_add(&bar[XB_XGEN(b.x)], 1u);
            asm volatile("s_waitcnt vmcnt(0)" ::: "memory");
        } else {
            XB_SPIN(xb_ld(&bar[XB_XGEN(b.x)]) == gen, bar);
            __builtin_amdgcn_fence(__ATOMIC_ACQUIRE, "agent");
            asm volatile("s_waitcnt vmcnt(0)" ::: "memory");
        }
    }
    __syncthreads();
}

constexpr int LDS_BAR_OFF = LDS_BYTES - 64;
__global__ void __launch_bounds__(NTHREADS, 2) mk_fwd(Args a) {
    extern __shared__ __attribute__((aligned(16))) unsigned char lds_raw[];
    LAS unsigned char* lds = (LAS unsigned char*)lds_raw;
    const int tid = threadIdx.x, lane = tid & 63, wave = __builtin_amdgcn_readfirstlane(tid >> 6);
    const int G = gridDim.x, bx = blockIdx.x, vcu = (G % 8 == 0) ? (bx % 8) * (G / 8) + bx / 8 : bx;
    const int gw = vcu * NWAVES + wave, NGW = G * NWAVES;
    unsigned char* ws = a.ws;
    if (tid < 16) ((LAS unsigned*)(lds + LDS_BAR_OFF))[tid] = 0u;
    __syncthreads();
    const XcdBarrier bar = xcd_barrier_post((unsigned*)(ws + WS_CTL) + CW_BAR, (volatile LAS unsigned*)(lds + LDS_BAR_OFF));
    const int lo = a.ph_lo, hi = a.ph_hi;
#define IN(k) (lo <= (k) && (k) < hi)
#define SEAM(k) do { if (IN(k) && IN((k) + 1)) xcd_barrier(bar); } while (0)
    if (IN(0)) phase_prep(a, lds, tid, lane, wave, vcu, G);
    SEAM(0);
    if (IN(1)) phase_ln1(a, lane, gw, NGW);
    SEAM(1);
    if (IN(2)) { bf16* proj = (bf16*)(ws + WS_PROJ);
        phase_gemm_dense((const bf16*)(ws + WS_HB), (const bf16*)(ws + WS_WIN), T, 2048, 1024, lds, tid, lane, wave, vcu, G,
            [&](int row, int col, f32x4 v) { u32x2 o; o.x = pk2(v.x, v.y); o.y = pk2(v.z, v.w); *(u32x2*)(proj + (size_t)row * 2048 + col) = o; }); }
    SEAM(2);
    if (IN(3)) phase_conv_gates(a, lane, gw, NGW);
    SEAM(3);
    if (IN(4)) phase_mlstm_local(a, lds, tid, vcu, G);
    SEAM(4);
    if (IN(5)) phase_scan(a, tid, vcu, G);
    SEAM(5);
    if (IN(6)) phase_mixer_out(a, lds, tid, vcu, G);
    SEAM(6);
    if (IN(7)) { bf16* mixo = (bf16*)(ws + WS_MIXO);
        phase_gemm_dense((const bf16*)(ws + WS_MIX), (const bf16*)(ws + WS_WOUT), T, 1024, 1024, lds, tid, lane, wave, vcu, G,
            [&](int row, int col, f32x4 v) { u32x2 o; o.x = pk2(v.x, v.y); o.y = pk2(v.z, v.w); *(u32x2*)(mixo + (size_t)row * 1024 + col) = o; }); }
    SEAM(7);
    if (IN(8)) phase_ln2(a, lane, gw, NGW);
    SEAM(8);
    if (IN(9)) { float* lg = (float*)(ws + WS_LOG);
        phase_gemm_dense((const bf16*)(ws + WS_H2), (const bf16*)(ws + WS_WR), T, 256, 1024, lds, tid, lane, wave, vcu, G,
            [&](int row, int col, f32x4 v) { *(f32x4*)(lg + (size_t)row * 256 + col) = v; }); }
    SEAM(9);
    if (IN(10)) phase_route(a, lane, gw, NGW);
    SEAM(10);
    if (IN(11)) phase_moe(a, lds, tid, lane, wave, vcu, G);
    SEAM(11);
    if (IN(12)) phase_final(a, lane, gw, NGW);
#undef IN
#undef SEAM
}

extern "C" void kernel_launch(void* const* d_in, const int* in_sizes, int n_in, void* d_out, int out_size, void* d_ws, size_t ws_size, hipStream_t stream) {
    static int grid = 0;
    if (grid == 0) {
        if (n_in != 31 || out_size != T * D || ws_size < WS_END) { fprintf(stderr, "kernel_launch: unexpected problem (n_in %d out %d ws %zu)\n", n_in, out_size, ws_size); grid = -1; return; }
        int dev = 0, cus = 0, per_cu = 0;
        if (hipGetDevice(&dev) != hipSuccess || hipDeviceGetAttribute(&cus, hipDeviceAttributeMultiprocessorCount, dev) != hipSuccess) { grid = -1; return; }
        if (hipFuncSetAttribute((const void*)mk_fwd, hipFuncAttributeMaxDynamicSharedMemorySize, LDS_BYTES) != hipSuccess) { fprintf(stderr, "kernel_launch: hipFuncSetAttribute failed\n"); grid = -1; return; }
        if (hipOccupancyMaxActiveBlocksPerMultiprocessor(&per_cu, (const void*)mk_fwd, NTHREADS, LDS_BYTES) != hipSuccess || per_cu < 1) fprintf(stderr, "kernel_launch: occupancy query reports %d\n", per_cu);
        (void)hipGetLastError();
        grid = cus;
    }
    if (grid < 0) return;
    (void)hipMemsetAsync((char*)d_ws + WS_CTL, 0, CTL_BYTES, stream);
    Args a{};
    for (int i = 0; i < 31; ++i) a.in[i] = (const float*)d_in[i];
    a.out = (float*)d_out; a.ws = (unsigned char*)d_ws; a.ph_lo = 0; a.ph_hi = NPHASE;
    hipLaunchKernelGGL(mk_fwd, dim3(grid), dim3(NTHREADS), LDS_BYTES, stream, a);
}
```

```cpp
#include <hip/hip_runtime.h>
#include <cstdio>
#include <cstdint>

#ifndef USE_MFMA
#define USE_MFMA 1
#endif

#ifndef ONLYPH
#define ONLYPH -1
#endif
#define PHEN(k) (ONLYPH < 0 || ONLYPH == (k))
#define LAS __attribute__((address_space(3)))
typedef unsigned short bf16;
typedef float f32x4 __attribute__((ext_vector_type(4)));
typedef short bf16x8 __attribute__((ext_vector_type(8)));
typedef unsigned u32x4 __attribute__((ext_vector_type(4)));
typedef unsigned u32x2 __attribute__((ext_vector_type(2)));

constexpr int NB = 4, SEQ = 8192, T = NB * SEQ, D = 1024;
constexpr int NH = 4, DH = 128, LCH = 128, NCH = SEQ / LCH;
constexpr int NE = 256, TOPK = 8, DE = 256;
constexpr float LN_EPS = 1e-5f, DN_ALPHA = 1.189207115002721f, ROUTE_SCALE = 2.5f, KSCALE = 0.08838834764831845f;
constexpr int NPHASE = 13;
constexpr int NTHREADS = 512, NWAVES = 8;
constexpr int LDS_BYTES = 155648;

constexpr size_t MiB = (size_t)1 << 20;
constexpr size_t WS_CTL = 0, CTL_BYTES = 1 * MiB;
constexpr size_t WS_MOD = 1 * MiB;
constexpr size_t WS_WG = 1 * MiB + 128 * 1024;
constexpr size_t WS_WIN = 2 * MiB;
constexpr size_t WS_WOUT = 6 * MiB;
constexpr size_t WS_WQKV = 8 * MiB;
constexpr size_t WS_WR = 9 * MiB;
constexpr size_t WS_WSP = 9 * MiB + 512 * 1024;
constexpr size_t WS_WSG = 10 * MiB;
constexpr size_t WS_WSU = 10 * MiB + 512 * 1024;
constexpr size_t WS_WSD = 11 * MiB;
constexpr size_t WS_WEG = 12 * MiB;
constexpr size_t WS_WEU = 140 * MiB;
constexpr size_t WS_WED = 268 * MiB;
constexpr size_t WS_H2 = 396 * MiB;
constexpr size_t WS_TOPI = 460 * MiB;
constexpr size_t WS_TOPW = 461 * MiB;
constexpr size_t WS_LIST = 462 * MiB;
constexpr size_t WS_LOG = 494 * MiB;
constexpr size_t WS_Y = 512 * MiB;
constexpr size_t WS_HB = 528 * MiB;
constexpr size_t WS_PROJ = 592 * MiB;
constexpr size_t WS_XC = 720 * MiB;
constexpr size_t WS_GATES = 752 * MiB;
constexpr size_t WS_QB = 754 * MiB;
constexpr size_t WS_CLOC = 786 * MiB;
constexpr size_t WS_NUML = 850 * MiB;
constexpr size_t WS_BCUM = 914 * MiB;
constexpr size_t WS_MLOC = 914 * MiB + 512 * 1024;
constexpr size_t WS_DEN = 915 * MiB;
constexpr size_t WS_GCH = 916 * MiB;
constexpr size_t WS_MLS = 916 * MiB + 4096;
constexpr size_t WS_MPREV = 916 * MiB + 8192;
constexpr size_t WS_NLOC = 916 * MiB + 512 * 1024;
constexpr size_t WS_NPREV = 917 * MiB;
constexpr size_t WS_CPREV = 918 * MiB;
constexpr size_t WS_MIX = 950 * MiB;
constexpr size_t WS_MIXO = WS_HB;
constexpr size_t WS_END = 1024 * MiB;

struct Args { const float* in[31]; float* out; unsigned char* ws; int ph_lo, ph_hi; };

__device__ __forceinline__ float bf2f(unsigned v) { return __uint_as_float(v << 16); }
__device__ __forceinline__ unsigned f2bf(float f) { unsigned u = __float_as_uint(f); return (u + 0x7fffu + ((u >> 16) & 1u)) >> 16; }
__device__ __forceinline__ unsigned pk2(float lo, float hi) { return f2bf(lo) | (f2bf(hi) << 16); }
__device__ __forceinline__ float rbf(float f) { return bf2f(f2bf(f)); }
__device__ __forceinline__ void unpack8(const u32x4 v, float (&o)[8]) {
    o[0] = __uint_as_float(v.x << 16); o[1] = __uint_as_float(v.x & 0xffff0000u);
    o[2] = __uint_as_float(v.y << 16); o[3] = __uint_as_float(v.y & 0xffff0000u);
    o[4] = __uint_as_float(v.z << 16); o[5] = __uint_as_float(v.z & 0xffff0000u);
    o[6] = __uint_as_float(v.w << 16); o[7] = __uint_as_float(v.w & 0xffff0000u);
}
__device__ __forceinline__ float wave_sum(float v) {
#pragma unroll
    for (int o = 1; o < 64; o <<= 1) v += __shfl_xor(v, o);
    return v;
}
__device__ __forceinline__ float wave_max(float v) {
#pragma unroll
    for (int o = 1; o < 64; o <<= 1) v = fmaxf(v, __shfl_xor(v, o));
    return v;
}
__device__ __forceinline__ float sigmoid_f(float x) { return 1.0f / (1.0f + __expf(-x)); }
__device__ __forceinline__ float silu_f(float x) { return x / (1.0f + __expf(-x)); }
__device__ __forceinline__ float gelu_f(float x) { return 0.5f * x * (1.0f + erff(x * 0.7071067811865476f)); }
__device__ __forceinline__ float logsigmoid_f(float x) { return fminf(x, 0.f) - log1pf(__expf(-fabsf(x))); }
#define LDS_WAIT() asm volatile("s_waitcnt lgkmcnt(0)" ::: "memory")

template <int CH> __device__ __forceinline__ int toff(int row, int chunk) {
    const int s = (CH == 4) ? ((row >> 1) & 3) : (CH == 8) ? (row & 7) : (row & 15);
    return row * (CH * 16) + ((chunk ^ s) << 4);
}
template <int CH> __device__ __forceinline__ u32x4 ld_chunk(const LAS unsigned char* tile, int row, int chunk) { return *(const LAS u32x4*)(tile + toff<CH>(row, chunk)); }
template <int CH> __device__ __forceinline__ void st_chunk(LAS unsigned char* tile, int row, int chunk, u32x4 v) { *(LAS u32x4*)(tile + toff<CH>(row, chunk)) = v; }
template <int CH> __device__ __forceinline__ float ld_elem(const LAS unsigned char* tile, int row, int col) { return bf2f(*(const LAS unsigned short*)(tile + toff<CH>(row, col >> 3) + (col & 7) * 2)); }
template <int CH> __device__ __forceinline__ void st_elem4(LAS unsigned char* tile, int row, int col  , float a, float b, float c, float d) {
    u32x2 v; v.x = pk2(a, b); v.y = pk2(c, d); *(LAS u32x2*)(tile + toff<CH>(row, col >> 3) + (col & 7) * 2) = v;
}
__device__ __forceinline__ float dot8(const float (&a)[8], const float (&b)[8], float acc) {
#pragma unroll
    for (int i = 0; i < 8; ++i) acc = fmaf(a[i], b[i], acc);
    return acc;
}

template <int NN, class FA, class FB>
__device__ __forceinline__ void core_naive(FA fa, FB fb, int K, f32x4 (&acc)[4][NN]) {
#pragma unroll
    for (int m = 0; m < 4; ++m)
#pragma unroll
        for (int n = 0; n < NN; ++n) acc[m][n] = (f32x4){0.f, 0.f, 0.f, 0.f};
    for (int k8 = 0; k8 < K / 8; ++k8) {
        float af[4][8];
#pragma unroll
        for (int m = 0; m < 4; ++m) unpack8(fa(m, k8), af[m]);
#pragma unroll
        for (int n = 0; n < NN; ++n)
#pragma unroll
            for (int r = 0; r < 4; ++r) {
                float bf[8]; unpack8(fb(n, r, k8), bf);
#pragma unroll
                for (int m = 0; m < 4; ++m) acc[m][n][r] = dot8(af[m], bf, acc[m][n][r]);
                asm volatile("" ::: "memory");
            }
    }
}

typedef __attribute__((address_space(1))) const unsigned gcu32;
template <int WM, int WN, int BK, bool A_LDS, int A_CH, class RA, class RB>
__device__ __forceinline__ void core_mfma(LAS unsigned char* stg, const LAS unsigned char* At, RA rowA, RB rowB, int K, f32x4 (&acc)[4][8], int tid, int lane, int wave) {
    constexpr int CH = BK / 8, RA_ROWS = A_LDS ? 0 : 64 * WM, RB_ROWS = 128 * WN;
    constexpr int NCHUNK = (RA_ROWS + RB_ROWS) * CH, NI = NCHUNK / 512, STAGE = NCHUNK * 16, A_BYTES = RA_ROWS * CH * 16, NIA = RA_ROWS * CH / 512;
    static_assert(NCHUNK % 512 == 0 && (RA_ROWS * CH) % 512 == 0, "tile chunks must split evenly over 512 threads");
    asm volatile("" : "+v"(tid));
    lane = tid & 63;
    const int wm = wave / WN, wn = wave % WN, fr = lane & 15, fq = lane >> 4;
    const bf16* src[NI];
#pragma unroll
    for (int i = 0; i < NI; ++i) {
        const int p = i * 512 + tid;
        if (i < NIA) { const int row = p / CH, cp = p % CH; const int s = (CH == 4) ? ((row >> 1) & 3) : (row & 7); src[i] = rowA(row) + ((cp ^ s) << 3); }
        else { const int q = p - RA_ROWS * CH, row = q / CH, cp = q % CH; const int s = (CH == 4) ? ((row >> 1) & 3) : (row & 7); src[i] = rowB(row) + ((cp ^ s) << 3); }
    }
#pragma unroll
    for (int m = 0; m < 4; ++m)
#pragma unroll
        for (int n = 0; n < 8; ++n) acc[m][n] = (f32x4){0.f, 0.f, 0.f, 0.f};
    const int nk = K / BK;
#define CM_ISSUE(s_, kt_) do { _Pragma("unroll") for (int i_ = 0; i_ < NI; ++i_) \
        __builtin_amdgcn_global_load_lds((gcu32*)(src[i_] + (kt_) * BK), (LAS unsigned*)(stg + (s_) * STAGE + (i_ * 512 + wave * 64) * 16), 16, 0, 0); } while (0)
    CM_ISSUE(0, 0);
    asm volatile("s_waitcnt vmcnt(0)" ::: "memory");
    __syncthreads();
    for (int kt = 0; kt < nk; ++kt) {
        const int s = kt & 1;
        if (kt + 1 < nk) CM_ISSUE(s ^ 1, kt + 1);
        const LAS unsigned char* As = A_LDS ? At : (const LAS unsigned char*)(stg + s * STAGE);
        const LAS unsigned char* Bs = stg + s * STAGE + A_BYTES;
#pragma unroll
        for (int kk = 0; kk < BK / 32; ++kk) {
            bf16x8 af[4], bfr[8];
#pragma unroll
            for (int m = 0; m < 4; ++m) {
                const int row = wm * 64 + 16 * m + fr;
                if (A_LDS) af[m] = *(const LAS bf16x8*)(As + toff<A_CH>(row, kt * CH + kk * 4 + fq));
                else af[m] = *(const LAS bf16x8*)(As + toff<CH>(row, kk * 4 + fq));
            }
#pragma unroll
            for (int n = 0; n < 8; ++n) bfr[n] = *(const LAS bf16x8*)(Bs + toff<CH>(wn * 128 + 16 * n + fr, kk * 4 + fq));
#pragma unroll
            for (int m = 0; m < 4; ++m)
#pragma unroll
                for (int n = 0; n < 8; ++n) acc[m][n] = __builtin_amdgcn_mfma_f32_16x16x32_bf16(bfr[n], af[m], acc[m][n], 0, 0, 0);
        }
        asm volatile("s_waitcnt vmcnt(0)" ::: "memory");
        __syncthreads();
    }
#undef CM_ISSUE
}

__device__ __forceinline__ void transpose_item(const float* W, int K, int N, bf16* WT, float scale, int item, int lane, LAS float* scr) {
    const int nblk = N / 32, kb = item / nblk, nb = item % nblk, k0 = 64 * kb, n0 = 32 * nb;
#pragma unroll 8
    for (int i = 0; i < 32; ++i) { const int kk = 2 * i + (lane >> 5); scr[kk * 33 + (lane & 31)] = W[(size_t)(k0 + kk) * N + n0 + (lane & 31)]; }
    LDS_WAIT();
    const int c = lane & 7;
#pragma unroll
    for (int j = 0; j < 4; ++j) {
        const int n = (lane >> 3) + 8 * j; const LAS float* s = scr + (8 * c) * 33 + n;
        u32x4 o; o.x = pk2(s[0 * 33] * scale, s[1 * 33] * scale); o.y = pk2(s[2 * 33] * scale, s[3 * 33] * scale);
        o.z = pk2(s[4 * 33] * scale, s[5 * 33] * scale); o.w = pk2(s[6 * 33] * scale, s[7 * 33] * scale);
        *(u32x4*)(WT + (size_t)(n0 + n) * K + k0 + 8 * c) = o;
    }
    LDS_WAIT();
}

__device__ __forceinline__ void phase_prep(const Args& a, LAS unsigned char* lds, int tid, int lane, int wave, int vcu, int G) {
    unsigned char* ws = a.ws;
    {
        LAS float* scr = (LAS float*)(lds + wave * 16384);
        const int gw = vcu * NWAVES + wave, NGW = G * NWAVES;
        constexpr int NITEMS = 1024 + 512 + 96 + 128 + 384 + 3 * 32768;
        for (int it = gw; it < NITEMS; it += NGW) {
            int r = it;
            if (r < 1024) { transpose_item(a.in[4], 1024, 2048, (bf16*)(ws + WS_WIN), 1.f, r, lane, scr); continue; } r -= 1024;
            if (r < 512) { transpose_item(a.in[18], 1024, 1024, (bf16*)(ws + WS_WOUT), 1.f, r, lane, scr); continue; } r -= 512;
            if (r < 96) { const int which = r / 32, rr = r % 32, h = rr / 8, ii = rr % 8;
                const float* src = (which == 0 ? a.in[7] : which == 1 ? a.in[8] : a.in[9]) + h * 16384;
                transpose_item(src, 128, 128, (bf16*)(ws + WS_WQKV) + (which * 4 + h) * 16384, which == 1 ? KSCALE : 1.f, ii, lane, scr); continue; } r -= 96;
            if (r < 128) { transpose_item(a.in[21], 1024, 256, (bf16*)(ws + WS_WR), 1.f, r, lane, scr); continue; } r -= 128;
            if (r < 128) { transpose_item(a.in[26], 1024, 256, (bf16*)(ws + WS_WSG), 1.f, r, lane, scr); continue; } r -= 128;
            if (r < 128) { transpose_item(a.in[27], 1024, 256, (bf16*)(ws + WS_WSU), 1.f, r, lane, scr); continue; } r -= 128;
            if (r < 128) { transpose_item(a.in[28], 256, 1024, (bf16*)(ws + WS_WSD), 1.f, r, lane, scr); continue; } r -= 128;
            if (r < 32768) { const int e = r >> 7; transpose_item(a.in[23] + (size_t)e * 262144, 1024, 256, (bf16*)(ws + WS_WEG) + (size_t)e * 262144, 1.f, r & 127, lane, scr); continue; } r -= 32768;
            if (r < 32768) { const int e = r >> 7; transpose_item(a.in[24] + (size_t)e * 262144, 1024, 256, (bf16*)(ws + WS_WEU) + (size_t)e * 262144, 1.f, r & 127, lane, scr); continue; } r -= 32768;
            { const int e = r >> 7; transpose_item(a.in[25] + (size_t)e * 262144, 256, 1024, (bf16*)(ws + WS_WED) + (size_t)e * 262144, 1.f, r & 127, lane, scr); }
        }
    }
    __syncthreads();
    {
        LAS float* sc = (LAS float*)lds;
        LAS float* part = (LAS float*)(lds + 16384);
        for (int it = vcu; it < 96; it += G) {
            __syncthreads();
            for (int i = tid; i < 4096; i += NTHREADS) sc[i] = silu_f(a.in[1][i]);
            __syncthreads();
            const int col = it * 64 + lane;
            float s0 = 0.f, s1 = 0.f, s2 = 0.f, s3 = 0.f;
            const float* wp = a.in[2] + (size_t)(wave * 128) * 6144 + col;
#pragma unroll 8
            for (int k = 0; k < 128; ++k) { const float w = wp[(size_t)k * 6144]; const int kk = wave * 128 + k;
                s0 = fmaf(sc[kk], w, s0); s1 = fmaf(sc[1024 + kk], w, s1); s2 = fmaf(sc[2048 + kk], w, s2); s3 = fmaf(sc[3072 + kk], w, s3); }
            part[(wave * 4 + 0) * 64 + lane] = s0; part[(wave * 4 + 1) * 64 + lane] = s1; part[(wave * 4 + 2) * 64 + lane] = s2; part[(wave * 4 + 3) * 64 + lane] = s3;
            __syncthreads();
            if (tid < 256) { const int b = tid >> 6, cl = tid & 63; float s = a.in[3][it * 64 + cl];
#pragma unroll
                for (int w = 0; w < 8; ++w) s += part[(w * 4 + b) * 64 + cl];
                ((float*)(ws + WS_MOD))[b * 6144 + it * 64 + cl] = s; }
        }
        __syncthreads();
    }
    {
        const int gt = vcu * NTHREADS + tid, NGT = G * NTHREADS;
        bf16* wsp = (bf16*)(ws + WS_WSP);
        for (int i = gt; i < 65536; i += NGT) { const int t = (i >> 7) & 127, s = i & 127; wsp[i] = (s <= t) ? (bf16)f2bf(a.in[16][i]) : (bf16)0; }
        float* wg = (float*)(ws + WS_WG);
        const float* wq = a.in[7]; const float* wk = a.in[8]; const float* wv = a.in[9]; const float* wif = a.in[10];
        for (int i = gt; i < 8192; i += NGT) {
            const int row = i >> 3, j = i & 7; float s = 0.f;
            if (row < 512) { const int h = row >> 7, d = row & 127; float sq = 0.f, sk = 0.f;
                for (int e = 0; e < 128; ++e) { sq = fmaf(wq[(h * 128 + d) * 128 + e], wif[(h * 128 + e) * 8 + j], sq); sk = fmaf(wk[(h * 128 + d) * 128 + e], wif[(512 + h * 128 + e) * 8 + j], sk); }
                s = sq + KSCALE * sk; }
            else { const int ch = row - 512, h = ch >> 7, d = ch & 127;
                for (int e = 0; e < 128; ++e) s = fmaf(wv[(h * 128 + d) * 128 + e], wif[(1024 + h * 128 + e) * 8 + j], s); }
            wg[i] = s;
        }
    }
}

__device__ __forceinline__ void phase_ln1(const Args& a, int lane, int gw, int NGW) {
    const float* mod = (const float*)(a.ws + WS_MOD); bf16* hb = (bf16*)(a.ws + WS_HB);
    for (int row = gw; row < T; row += NGW) {
        const int b = row >> 13;
        const f32x4* xr = (const f32x4*)(a.in[0] + (size_t)row * D) + lane;
        f32x4 v[4]; float s = 0.f;
#pragma unroll
        for (int j = 0; j < 4; ++j) { v[j] = xr[64 * j]; s += (v[j].x + v[j].y) + (v[j].z + v[j].w); }
        const float mean = wave_sum(s) * (1.f / D); float s2 = 0.f;
#pragma unroll
        for (int j = 0; j < 4; ++j) { v[j] = v[j] - mean; s2 += (v[j].x * v[j].x + v[j].y * v[j].y) + (v[j].z * v[j].z + v[j].w * v[j].w); }
        const float rstd = 1.f / sqrtf(wave_sum(s2) * (1.f / D) + LN_EPS);
        u32x2* o8 = (u32x2*)(hb + (size_t)row * D) + lane;
#pragma unroll
        for (int j = 0; j < 4; ++j) { const int col = 4 * lane + 256 * j;
            const f32x4 sh = *(const f32x4*)(mod + b * 6144 + col), sc = *(const f32x4*)(mod + b * 6144 + 1024 + col);
            const f32x4 h = v[j] * rstd * (sc + 1.0f) + sh; u32x2 w; w.x = pk2(h.x, h.y); w.y = pk2(h.z, h.w); o8[64 * j] = w; }
    }
}

template <class Epi>
__device__ __forceinline__ void phase_gemm_dense(const bf16* A, const bf16* Bt, int Mrows, int N, int K, LAS unsigned char* lds, int tid, int lane, int wave, int vcu, int G, Epi epi) {
    const int nM = Mrows / 256, nN = N / 256, wm = wave >> 1, wn = wave & 1, fr = lane & 15, fq = lane >> 4;
    for (int it = vcu; it < nM * nN; it += G) {
        const int pm = it / nN, pn = it % nN;
#if USE_MFMA
        f32x4 acc[4][8];
        const bf16* Ab = A + (size_t)(pm * 256) * K; const bf16* Bb = Bt + (size_t)(pn * 256) * K;
        core_mfma<4, 2, 64, false, 8>(lds, nullptr, [&](int r) { return Ab + (size_t)r * K; }, [&](int r) { return Bb + (size_t)r * K; }, K, acc, tid, lane, wave);
#pragma unroll
        for (int m = 0; m < 4; ++m)
#pragma unroll
            for (int n = 0; n < 8; ++n) epi(pm * 256 + wm * 64 + 16 * m + fr, pn * 256 + wn * 128 + 16 * n + 4 * fq, acc[m][n]);
#else
        const bf16* Ab = A + (size_t)(pm * 256 + wm * 64 + fr) * K;
        const bf16* Bb = Bt + (size_t)(pn * 256 + wn * 128 + 4 * fq) * K;
#pragma unroll 1
        for (int nq = 0; nq < 4; ++nq) {
            f32x4 acc[4][2];
            core_naive<2>([&](int m, int k8) { return *(const u32x4*)(Ab + (size_t)(16 * m) * K + 8 * k8); },
                          [&](int n, int r, int k8) { return *(const u32x4*)(Bb + (size_t)(16 * (2 * nq + n) + r) * K + 8 * k8); }, K, acc);
#pragma unroll
            for (int m = 0; m < 4; ++m)
#pragma unroll
                for (int n = 0; n < 2; ++n) epi(pm * 256 + wm * 64 + 16 * m + fr, pn * 256 + wn * 128 + 16 * (2 * nq + n) + 4 * fq, acc[m][n]);
        }
#endif
    }
}

__device__ __forceinline__ void phase_conv_gates(const Args& a, int lane, int gw, int NGW) {
    const bf16* proj = (const bf16*)(a.ws + WS_PROJ); bf16* xcb = (bf16*)(a.ws + WS_XC); float* gates = (float*)(a.ws + WS_GATES);
    const float* wg = (const float*)(a.ws + WS_WG); const float* cw = a.in[5]; const float* cb = a.in[6]; const float* bif = a.in[11];
    const int ch = lane * 8;
    for (int tok = gw; tok < T; tok += NGW) {
        const int ts = tok & (SEQ - 1);
        float acc[8], xm[8];
#pragma unroll
        for (int i = 0; i < 8; ++i) { acc[i] = cb[ch + i]; xm[i] = 0.f; }
#pragma unroll
        for (int j = 0; j < 4; ++j) {
            if (ts - 3 + j >= 0) {
                float v[8]; unpack8(*(const u32x4*)(proj + (size_t)(tok - 3 + j) * 2048 + ch), v);
#pragma unroll
                for (int i = 0; i < 8; ++i) { acc[i] = fmaf(cw[j * 512 + ch + i], v[i], acc[i]); if (j == 3) xm[i] = v[i]; }
            }
        }
        float xc[8];
#pragma unroll
        for (int i = 0; i < 8; ++i) xc[i] = rbf(silu_f(acc[i]));
        u32x4 o; o.x = pk2(xc[0], xc[1]); o.y = pk2(xc[2], xc[3]); o.z = pk2(xc[4], xc[5]); o.w = pk2(xc[6], xc[7]);
        *(u32x4*)(xcb + (size_t)tok * 512 + ch) = o;
        float g[8];
#pragma unroll
        for (int j = 0; j < 8; ++j) g[j] = 0.f;
#pragma unroll
        for (int i = 0; i < 8; ++i) {
            const f32x4 w1a = *(const f32x4*)(wg + (ch + i) * 8), w1b = *(const f32x4*)(wg + (ch + i) * 8 + 4);
            const f32x4 w2a = *(const f32x4*)(wg + (512 + ch + i) * 8), w2b = *(const f32x4*)(wg + (512 + ch + i) * 8 + 4);
            g[0] += xc[i] * w1a.x + xm[i] * w2a.x; g[1] += xc[i] * w1a.y + xm[i] * w2a.y; g[2] += xc[i] * w1a.z + xm[i] * w2a.z; g[3] += xc[i] * w1a.w + xm[i] * w2a.w;
            g[4] += xc[i] * w1b.x + xm[i] * w2b.x; g[5] += xc[i] * w1b.y + xm[i] * w2b.y; g[6] += xc[i] * w1b.z + xm[i] * w2b.z; g[7] += xc[i] * w1b.w + xm[i] * w2b.w;
        }
#pragma unroll
        for (int j = 0; j < 8; ++j) g[j] = wave_sum(g[j]);
        if (lane == 0) {
            f32x4 o0 = {g[0] + bif[0], g[1] + bif[1], g[2] + bif[2], g[3] + bif[3]}, o1 = {g[4] + bif[4], g[5] + bif[5], g[6] + bif[6], g[7] + bif[7]};
            *(f32x4*)(gates + (size_t)tok * 8) = o0; *(f32x4*)(gates + (size_t)tok * 8 + 4) = o1;
        }
    }
}

__device__ __forceinline__ void mm_nt_g(const LAS unsigned char* A, const bf16* Bg, int tid, float (&o)[32]) {
    const int t = tid >> 2, j0 = (tid & 3) * 32;
#pragma unroll
    for (int i = 0; i < 32; ++i) o[i] = 0.f;
    for (int c = 0; c < 16; ++c) {
        float af[8]; unpack8(ld_chunk<16>(A, t, c), af);
#pragma unroll
        for (int i = 0; i < 32; ++i) { float bf[8]; unpack8(*(const u32x4*)(Bg + (size_t)(j0 + i) * 128 + 8 * c), bf); o[i] = dot8(af, bf, o[i]); if ((i & 3) == 3) asm volatile("" ::: "memory"); }
    }
}
__device__ __forceinline__ void mm_nt_l(const LAS unsigned char* A, const LAS unsigned char* B, int tid, float (&o)[32]) {
    const int t = tid >> 2, j0 = (tid & 3) * 32;
#pragma unroll
    for (int i = 0; i < 32; ++i) o[i] = 0.f;
    for (int c = 0; c < 16; ++c) {
        float af[8]; unpack8(ld_chunk<16>(A, t, c), af);
#pragma unroll
        for (int i = 0; i < 32; ++i) { float bf[8]; unpack8(ld_chunk<16>(B, j0 + i, c), bf); o[i] = dot8(af, bf, o[i]); if ((i & 3) == 3) asm volatile("" ::: "memory"); }
    }
}
__device__ __forceinline__ void mm_nn_l(const LAS unsigned char* P, const LAS unsigned char* V, int tid, int slim, float (&o)[32]) {
    const int t = tid >> 2, c0 = (tid & 3) * 4;
#pragma unroll
    for (int i = 0; i < 32; ++i) o[i] = 0.f;
    for (int s = 0; s < slim; ++s) {
        const float p = ld_elem<16>(P, t, s);
#pragma unroll
        for (int cc = 0; cc < 4; ++cc) { float vf[8]; unpack8(ld_chunk<16>(V, s, c0 + cc), vf);
#pragma unroll
            for (int e = 0; e < 8; ++e) o[cc * 8 + e] = fmaf(p, vf[e], o[cc * 8 + e]); }
    }
}

__device__ __forceinline__ void phase_mlstm_local(const Args& a, LAS unsigned char* lds, int tid, int vcu, int G) {
    unsigned char* ws = a.ws;
    const bf16* proj = (const bf16*)(ws + WS_PROJ); const bf16* xcb = (const bf16*)(ws + WS_XC); const float* gates = (const float*)(ws + WS_GATES);
    bf16* qb = (bf16*)(ws + WS_QB); float* cloc = (float*)(ws + WS_CLOC); float* numl = (float*)(ws + WS_NUML);
    LAS unsigned char* TX = lds; LAS unsigned char* TQ = lds + 32768; LAS unsigned char* TK = lds + 65536; LAS unsigned char* TV = lds + 98304;
    LAS float* F = (LAS float*)(lds + 131072);
    LAS float* ipre = F; LAS float* bcum = F + 128; LAS float* wexp = F + 256; LAS float* uu = F + 384; LAS float* cm = F + 512; LAS float* misc = F + 640;
    const int t = tid >> 2, j0 = (tid & 3) * 32;
    for (int it = vcu; it < NB * NCH * NH; it += G) {
        const int h = it & 3, c = (it >> 2) & 63, b = it >> 8;
        const int t0 = b * SEQ + c * LCH; const int bhc = (b * NH + h) * NCH + c;
        __syncthreads();
        for (int i = tid; i < 2048; i += NTHREADS) { const int r = i >> 4, ch = i & 15; st_chunk<16>(TX, r, ch, *(const u32x4*)(xcb + (size_t)(t0 + r) * 512 + h * 128 + ch * 8)); }
        if (tid < 128) {
            const float ip = gates[(size_t)(t0 + tid) * 8 + h], fp = gates[(size_t)(t0 + tid) * 8 + 4 + h];
            ipre[tid] = ip; bcum[tid] = logsigmoid_f(fp);
        }
        __syncthreads();
        if (tid == 0) {
            float s = 0.f; for (int i = 0; i < 128; ++i) { s += bcum[i]; bcum[i] = s; }
            const float g = s; float mx = -3.0e38f, run = -3.0e38f;
            for (int i = 0; i < 128; ++i) { const float av = g - bcum[i] + ipre[i]; wexp[i] = av; mx = fmaxf(mx, av); const float u = ipre[i] - bcum[i]; uu[i] = u; run = fmaxf(run, u); cm[i] = run; }
            for (int i = 0; i < 128; ++i) wexp[i] = __expf(wexp[i] - mx);
            misc[0] = g; misc[1] = mx;
            ((float*)(ws + WS_GCH))[bhc] = g; ((float*)(ws + WS_MLS))[bhc] = mx;
        }
        float o[32];
        mm_nt_g(TX, (const bf16*)(ws + WS_WQKV) + (0 * 4 + h) * 16384, tid, o);
#pragma unroll
        for (int i = 0; i < 32; i += 4) st_elem4<16>(TQ, t, j0 + i, o[i], o[i + 1], o[i + 2], o[i + 3]);
#pragma unroll
        for (int i = 0; i < 32; i += 8) { u32x4 w; w.x = pk2(o[i], o[i + 1]); w.y = pk2(o[i + 2], o[i + 3]); w.z = pk2(o[i + 4], o[i + 5]); w.w = pk2(o[i + 6], o[i + 7]);
            *(u32x4*)(qb + (size_t)(t0 + t) * 512 + h * 128 + j0 + i) = w; }
        mm_nt_g(TX, (const bf16*)(ws + WS_WQKV) + (1 * 4 + h) * 16384, tid, o);
#pragma unroll
        for (int i = 0; i < 32; i += 4) st_elem4<16>(TK, t, j0 + i, o[i], o[i + 1], o[i + 2], o[i + 3]);
        __syncthreads();
        for (int i = tid; i < 2048; i += NTHREADS) { const int r = i >> 4, ch = i & 15; st_chunk<16>(TX, r, ch, *(const u32x4*)(proj + (size_t)(t0 + r) * 2048 + h * 128 + ch * 8)); }
        __syncthreads();
        mm_nt_g(TX, (const bf16*)(ws + WS_WQKV) + (2 * 4 + h) * 16384, tid, o);
#pragma unroll
        for (int i = 0; i < 32; i += 4) st_elem4<16>(TV, t, j0 + i, o[i], o[i + 1], o[i + 2], o[i + 3]);
        __syncthreads();
        {
#pragma unroll
            for (int i = 0; i < 32; ++i) o[i] = 0.f;
            for (int l = 0; l < 128; ++l) {
                const float vv = ld_elem<16>(TV, l, t) * wexp[l];
#pragma unroll
                for (int cc = 0; cc < 4; ++cc) { float kf[8]; unpack8(ld_chunk<16>(TK, l, (tid & 3) * 4 + cc), kf);
#pragma unroll
                    for (int e = 0; e < 8; ++e) o[cc * 8 + e] = fmaf(vv, kf[e], o[cc * 8 + e]); }
            }
            float* cp = cloc + (size_t)bhc * 16384 + t * 128 + j0;
#pragma unroll
            for (int i = 0; i < 32; i += 4) *(f32x4*)(cp + i) = (f32x4){o[i], o[i + 1], o[i + 2], o[i + 3]};
            if (tid < 128) { float s = 0.f; for (int l = 0; l < 128; ++l) s = fmaf(wexp[l], ld_elem<16>(TK, l, tid), s); ((float*)(ws + WS_NLOC))[(size_t)bhc * 128 + tid] = s; }
        }
        mm_nt_l(TQ, TK, tid, o);
        float den = 0.f;
        {
            const float cmt = cm[t];
#pragma unroll
            for (int i = 0; i < 32; ++i) { const int s = j0 + i; float p = (s <= t) ? __expf(uu[s] - cmt) * o[i] : 0.f; p = rbf(p); o[i] = p; den += p; }
            den += __shfl_xor(den, 1); den += __shfl_xor(den, 2);
        }
        __syncthreads();
#pragma unroll
        for (int i = 0; i < 32; i += 4) st_elem4<16>(TX, t, j0 + i, o[i], o[i + 1], o[i + 2], o[i + 3]);
        __syncthreads();
        mm_nn_l(TX, TV, tid, 128, o);
        {
            float* np = numl + (size_t)(t0 + t) * 512 + h * 128 + j0;
#pragma unroll
            for (int i = 0; i < 32; i += 4) *(f32x4*)(np + i) = (f32x4){o[i], o[i + 1], o[i + 2], o[i + 3]};
            if ((tid & 3) == 0) {
                ((float*)(ws + WS_BCUM))[(size_t)(t0 + t) * 4 + h] = bcum[t];
                ((float*)(ws + WS_MLOC))[(size_t)(t0 + t) * 4 + h] = bcum[t] + cm[t];
                ((float*)(ws + WS_DEN))[(size_t)(t0 + t) * 4 + h] = den;
            }
        }
    }
}

__device__ __forceinline__ void phase_scan(const Args& a, int tid, int vcu, int G) {
    unsigned char* ws = a.ws;
    const float* gch = (const float*)(ws + WS_GCH); const float* mls = (const float*)(ws + WS_MLS);
    const float* cloc = (const float*)(ws + WS_CLOC); bf16* cprev = (bf16*)(ws + WS_CPREV);
    const float* nloc = (const float*)(ws + WS_NLOC); float* nprev = (float*)(ws + WS_NPREV); float* mprev = (float*)(ws + WS_MPREV);
    for (int it = vcu; it < 512 + 4; it += G) {
        if (it < 512) {
            const int bh = it >> 5, e = (it & 31) * 512 + tid;
            float m = 0.f, C = 0.f;
            for (int c = 0; c < NCH; ++c) {
                const size_t idx = (size_t)(bh * NCH + c) * 16384 + e;
                cprev[idx] = (bf16)f2bf(C);
                const float g = gch[bh * NCH + c], ml = mls[bh * NCH + c], mn = fmaxf(g + m, ml);
                C = __expf(g + m - mn) * C + __expf(ml - mn) * cloc[idx]; m = mn;
            }
        } else {
            const int gi = (it - 512) * 512 + tid, bh = gi >> 7, e = gi & 127;
            float m = 0.f, n = 0.f;
            for (int c = 0; c < NCH; ++c) {
                const size_t idx = (size_t)(bh * NCH + c) * 128 + e;
                nprev[idx] = n; if (e == 0) mprev[bh * NCH + c] = m;
                const float g = gch[bh * NCH + c], ml = mls[bh * NCH + c], mn = fmaxf(g + m, ml);
                n = __expf(g + m - mn) * n + __expf(ml - mn) * nloc[idx]; m = mn;
            }
        }
    }
}

__device__ __forceinline__ void phase_mixer_out(const Args& a, LAS unsigned char* lds, int tid, int vcu, int G) {
    unsigned char* ws = a.ws;
    const bf16* proj = (const bf16*)(ws + WS_PROJ); const bf16* xcb = (const bf16*)(ws + WS_XC); const bf16* qb = (const bf16*)(ws + WS_QB);
    const bf16* cprev = (const bf16*)(ws + WS_CPREV); const float* numl = (const float*)(ws + WS_NUML); bf16* mix = (bf16*)(ws + WS_MIX);
    LAS unsigned char* TQ = lds; LAS unsigned char* TC = lds + 32768; LAS unsigned char* TV = lds + 65536;
    const int t = tid >> 2, j0 = (tid & 3) * 32;
    for (int it = vcu; it < NB * NCH * NH; it += G) {
        const int h = it & 3, c = (it >> 2) & 63, b = it >> 8;
        const int t0 = b * SEQ + c * LCH; const int bhc = (b * NH + h) * NCH + c; const int tok = t0 + t;
        __syncthreads();
        for (int i = tid; i < 2048; i += NTHREADS) { const int r = i >> 4, ch = i & 15;
            st_chunk<16>(TQ, r, ch, *(const u32x4*)(qb + (size_t)(t0 + r) * 512 + h * 128 + ch * 8));
            st_chunk<16>(TC, r, ch, *(const u32x4*)(cprev + (size_t)bhc * 16384 + r * 128 + ch * 8)); }
        {
            float vg[32]; float s = 0.f;
#pragma unroll
            for (int i = 0; i < 32; i += 8) { float vf[8];
                unpack8(*(const u32x4*)(proj + (size_t)tok * 2048 + 1536 + h * 128 + j0 + i), vf);
#pragma unroll
                for (int e = 0; e < 8; ++e) { vg[i + e] = gelu_f(vf[e]); s += vg[i + e]; } }
            s += __shfl_xor(s, 1); s += __shfl_xor(s, 2);
            const float mean = s * (1.f / 128.f); float q = 0.f;
#pragma unroll
            for (int i = 0; i < 32; ++i) { vg[i] -= mean; q += vg[i] * vg[i]; }
            q += __shfl_xor(q, 1); q += __shfl_xor(q, 2);
            const float rstd = 1.f / sqrtf(q * (1.f / 128.f) + LN_EPS);
#pragma unroll
            for (int i = 0; i < 32; ++i) vg[i] = vg[i] * rstd * a.in[14][h * 128 + j0 + i] + a.in[15][h * 128 + j0 + i];
#pragma unroll
            for (int i = 0; i < 32; i += 4) st_elem4<16>(TV, t, j0 + i, vg[i], vg[i + 1], vg[i + 2], vg[i + 3]);
        }
        __syncthreads();
        float o[32];
        mm_nt_l(TQ, TC, tid, o);
        {
            float nqi = 0.f;
            const float* np = (const float*)(ws + WS_NPREV) + (size_t)bhc * 128;
#pragma unroll
            for (int i = 0; i < 32; ++i) nqi = fmaf(ld_elem<16>(TQ, t, j0 + i), np[j0 + i], nqi);
            nqi += __shfl_xor(nqi, 1); nqi += __shfl_xor(nqi, 2);
            const float mp = ((const float*)(ws + WS_MPREV))[bhc];
            const float bc = ((const float*)(ws + WS_BCUM))[(size_t)tok * 4 + h], ml = ((const float*)(ws + WS_MLOC))[(size_t)tok * 4 + h], den = ((const float*)(ws + WS_DEN))[(size_t)tok * 4 + h];
            const float mt = fmaxf(bc + mp, ml), wi = __expf(bc + mp - mt), wl = __expf(ml - mt);
            const float nq = wi * nqi + wl * den, dn = 1.f / fmaxf(fabsf(nq), __expf(-mt));
            const float* nlp = numl + (size_t)tok * 512 + h * 128 + j0;
            float s = 0.f;
#pragma unroll
            for (int i = 0; i < 32; ++i) { o[i] = (wi * o[i] + wl * nlp[i]) * dn; s += o[i]; }
            s += __shfl_xor(s, 1); s += __shfl_xor(s, 2);
            const float mean = s * (1.f / 128.f); float q = 0.f;
#pragma unroll
            for (int i = 0; i < 32; ++i) { o[i] -= mean; q += o[i] * o[i]; }
            q += __shfl_xor(q, 1); q += __shfl_xor(q, 2);
            const float rstd = 1.f / sqrtf(q * (1.f / 128.f) + LN_EPS);
#pragma unroll
            for (int i = 0; i < 32; i += 8) {
                float zf[8], xf[8], r[8];
                unpack8(*(const u32x4*)(proj + (size_t)tok * 2048 + 512 + h * 128 + j0 + i), zf); unpack8(*(const u32x4*)(xcb + (size_t)tok * 512 + h * 128 + j0 + i), xf);
#pragma unroll
                for (int e = 0; e < 8; ++e) { const int ch = h * 128 + j0 + i + e; const float hc = o[i + e] * rstd * a.in[12][ch]; r[e] = sigmoid_f(zf[e]) * (hc + a.in[13][ch] * xf[e]); }
                u32x4 w; w.x = pk2(r[0], r[1]); w.y = pk2(r[2], r[3]); w.z = pk2(r[4], r[5]); w.w = pk2(r[6], r[7]);
                *(u32x4*)(mix + (size_t)tok * 1024 + h * 128 + j0 + i) = w;
            }
        }
        {
            const bf16* wrow = (const bf16*)(ws + WS_WSP) + (size_t)h * 16384 + t * 128;
#pragma unroll
            for (int i = 0; i < 32; ++i) o[i] = 0.f;
            for (int s = 0; s <= t; ++s) {
                const float p = bf2f(wrow[s]);
#pragma unroll
                for (int cc = 0; cc < 4; ++cc) { float vf[8]; unpack8(ld_chunk<16>(TV, s, (tid & 3) * 4 + cc), vf);
#pragma unroll
                    for (int e = 0; e < 8; ++e) o[cc * 8 + e] = fmaf(p, vf[e], o[cc * 8 + e]); }
            }
            const float bsp = a.in[17][h * 128 + t];
#pragma unroll
            for (int i = 0; i < 32; i += 8) { u32x4 w; float ug[8];
                unpack8(*(const u32x4*)(proj + (size_t)tok * 2048 + 1024 + h * 128 + j0 + i), ug);
#pragma unroll
                for (int e = 0; e < 8; ++e) ug[e] = gelu_f(ug[e]);
                w.x = pk2(ug[0] * (o[i] + bsp), ug[1] * (o[i + 1] + bsp)); w.y = pk2(ug[2] * (o[i + 2] + bsp), ug[3] * (o[i + 3] + bsp));
                w.z = pk2(ug[4] * (o[i + 4] + bsp), ug[5] * (o[i + 5] + bsp)); w.w = pk2(ug[6] * (o[i + 6] + bsp), ug[7] * (o[i + 7] + bsp));
                *(u32x4*)(mix + (size_t)tok * 1024 + 512 + h * 128 + j0 + i) = w; }
        }
    }
}

__device__ __forceinline__ void phase_ln2(const Args& a, int lane, int gw, int NGW) {
    const float* mod = (const float*)(a.ws + WS_MOD); const bf16* mixo = (const bf16*)(a.ws + WS_MIXO); bf16* h2 = (bf16*)(a.ws + WS_H2);
    for (int row = gw; row < T; row += NGW) {
        const int b = row >> 13;
        const f32x4* xr = (const f32x4*)(a.in[0] + (size_t)row * D) + lane; const u32x2* mr = (const u32x2*)(mixo + (size_t)row * D) + lane;
        f32x4 v[4]; float s = 0.f;
#pragma unroll
        for (int j = 0; j < 4; ++j) { const int col = 4 * lane + 256 * j; const f32x4 x = xr[64 * j]; const u32x2 m = mr[64 * j];
            const f32x4 gt = *(const f32x4*)(mod + b * 6144 + 2048 + col);
            const f32x4 mv = {bf2f(m.x & 0xffffu), bf2f(m.x >> 16), bf2f(m.y & 0xffffu), bf2f(m.y >> 16)};
            v[j] = x * DN_ALPHA + (gt + 1.0f) * mv; s += (v[j].x + v[j].y) + (v[j].z + v[j].w); }
        float mean = wave_sum(s) * (1.f / D), s2 = 0.f;
#pragma unroll
        for (int j = 0; j < 4; ++j) { v[j] = v[j] - mean; s2 += (v[j].x * v[j].x + v[j].y * v[j].y) + (v[j].z * v[j].z + v[j].w * v[j].w); }
        float rstd = 1.f / sqrtf(wave_sum(s2) * (1.f / D) + LN_EPS);
        f32x4* xo = (f32x4*)(a.out + (size_t)row * D) + lane; s = 0.f;
#pragma unroll
        for (int j = 0; j < 4; ++j) { const int col = 4 * lane + 256 * j;
            v[j] = v[j] * rstd * *(const f32x4*)(a.in[19] + col) + *(const f32x4*)(a.in[20] + col); xo[64 * j] = v[j]; s += (v[j].x + v[j].y) + (v[j].z + v[j].w); }
        mean = wave_sum(s) * (1.f / D); s2 = 0.f;
#pragma unroll
        for (int j = 0; j < 4; ++j) { v[j] = v[j] - mean; s2 += (v[j].x * v[j].x + v[j].y * v[j].y) + (v[j].z * v[j].z + v[j].w * v[j].w); }
        rstd = 1.f / sqrtf(wave_sum(s2) * (1.f / D) + LN_EPS);
        u32x2* o8 = (u32x2*)(h2 + (size_t)row * D) + lane;
#pragma unroll
        for (int j = 0; j < 4; ++j) { const int col = 4 * lane + 256 * j;
            const f32x4 sh = *(const f32x4*)(mod + b * 6144 + 3072 + col), sc = *(const f32x4*)(mod + b * 6144 + 4096 + col);
            const f32x4 h = v[j] * rstd * (sc + 1.0f) + sh; u32x2 w; w.x = pk2(h.x, h.y); w.y = pk2(h.z, h.w); o8[64 * j] = w; }
    }
}

__device__ __forceinline__ void phase_route(const Args& a, int lane, int gw, int NGW) {
    unsigned char* ws = a.ws;
    const float* logits = (const float*)(ws + WS_LOG); const float* ebias = a.in[22];
    unsigned* cnt = (unsigned*)(ws + WS_CTL); int* topi = (int*)(ws + WS_TOPI); float* topw = (float*)(ws + WS_TOPW); int* list = (int*)(ws + WS_LIST);
    const f32x4 eb = *(const f32x4*)(ebias + lane * 4);
    for (int tok = gw; tok < T; tok += NGW) {
        const f32x4 lg = *(const f32x4*)(logits + (size_t)tok * 256 + lane * 4);
        float sc[4] = {sigmoid_f(lg.x), sigmoid_f(lg.y), sigmoid_f(lg.z), sigmoid_f(lg.w)};
        float sel[4] = {sc[0] + eb.x, sc[1] + eb.y, sc[2] + eb.z, sc[3] + eb.w};
        float m1 = fmaxf(sel[0], sel[1]), m2 = fminf(sel[0], sel[1]);
        { const float c = sel[2]; if (c > m1) { m2 = m1; m1 = c; } else if (c > m2) m2 = c; }
        { const float c = sel[3]; if (c > m1) { m2 = m1; m1 = c; } else if (c > m2) m2 = c; }
#pragma unroll
        for (int o = 1; o < 8; o <<= 1) { const float b1 = __shfl_xor(m1, o), b2 = __shfl_xor(m2, o); const float n1 = fmaxf(m1, b1), n2 = fmaxf(fminf(m1, b1), fmaxf(m2, b2)); m1 = n1; m2 = n2; }
        const float gs = m1 + m2; const int mygrp = lane >> 3; int rank = 0;
#pragma unroll
        for (int g = 0; g < 8; ++g) { const float og = __shfl(gs, g * 8); rank += (og > gs || (og == gs && g < mygrp)) ? 1 : 0; }
        const bool allowed = rank < 4;
#pragma unroll
        for (int i = 0; i < 4; ++i) if (!allowed) sel[i] = -INFINITY;
        int myE = 0; float myS = 0.f, ssum = 0.f;
#pragma unroll 1
        for (int k = 0; k < TOPK; ++k) {
            float bv = sel[0]; int bi = lane * 4;
            if (sel[1] > bv) { bv = sel[1]; bi = lane * 4 + 1; }
            if (sel[2] > bv) { bv = sel[2]; bi = lane * 4 + 2; }
            if (sel[3] > bv) { bv = sel[3]; bi = lane * 4 + 3; }
#pragma unroll
            for (int o = 1; o < 64; o <<= 1) { const float ov = __shfl_xor(bv, o); const int oi = __shfl_xor(bi, o); if (ov > bv || (ov == bv && oi < bi)) { bv = ov; bi = oi; } }
            const int sub = bi & 3; const float mysc = sub == 0 ? sc[0] : sub == 1 ? sc[1] : sub == 2 ? sc[2] : sc[3];
            const float wsc = __shfl(mysc, bi >> 2);
            if ((bi >> 2) == lane) { if (sub == 0) sel[0] = -INFINITY; else if (sub == 1) sel[1] = -INFINITY; else if (sub == 2) sel[2] = -INFINITY; else sel[3] = -INFINITY; }
            if (lane == k) { myE = bi; myS = wsc; }
            ssum += wsc;
        }
        if (lane < TOPK) {
            const float w = myS / ssum * ROUTE_SCALE;
            topi[(size_t)tok * 8 + lane] = myE; topw[(size_t)tok * 8 + lane] = w;
            const unsigned pos = atomicAdd(&cnt[myE], 1u);
            list[(size_t)myE * 32768 + pos] = tok * 8 + lane;
        }
    }
}

template <bool SHARED>
__device__ __forceinline__ void moe_item(const Args& a, LAS unsigned char* lds, LAS unsigned char* HT, const LAS int* sEnt, const LAS float* sW, const bf16* Wg, const bf16* Wu, const bf16* Wd, int tid, int lane, int wave) {
    unsigned char* ws = a.ws;
    const bf16* h2 = (const bf16*)(ws + WS_H2); bf16* Y = (bf16*)(ws + WS_Y); const float* mod = (const float*)(ws + WS_MOD);
    asm volatile("" : "+v"(tid)); lane = tid & 63;
    const int wm = wave >> 2, wn = wave & 3, fr = lane & 15, fq = lane >> 4;
#if USE_MFMA
    f32x4 acc[4][8];
    core_mfma<2, 4, 32, false, 4>(lds, nullptr,
        [&](int r) { int ent = sEnt[r]; if (ent < 0) ent = -1 - ent; const int tokr = SHARED ? ent : (ent >> 3); return h2 + (size_t)tokr * 1024; },
        [&](int r) { const int wq = r >> 7, x = r & 127; return (x < 64) ? Wg + (size_t)(wq * 64 + x) * 1024 : Wu + (size_t)(wq * 64 + x - 64) * 1024; }, 1024, acc, tid, lane, wave);
#pragma unroll
    for (int m = 0; m < 4; ++m)
#pragma unroll
        for (int n = 0; n < 4; ++n) { const f32x4 g = acc[m][n], u = acc[m][n + 4];
            st_elem4<32>(HT, wm * 64 + 16 * m + fr, wn * 64 + 16 * n + 4 * fq, silu_f(g.x) * u.x, silu_f(g.y) * u.y, silu_f(g.z) * u.z, silu_f(g.w) * u.w); }
    __syncthreads();
#pragma unroll 1
    for (int nh = 0; nh < 2; ++nh) {
        const bf16* Wdb = Wd + (size_t)(nh * 512) * 256;
        core_mfma<2, 4, 32, true, 32>(lds, HT, [&](int r) { return (const bf16*)nullptr; }, [&](int r) { return Wdb + (size_t)r * 256; }, 256, acc, tid, lane, wave);
#pragma unroll
        for (int m = 0; m < 4; ++m) {
            const int row = wm * 64 + 16 * m + fr; const int ent = sEnt[row];
            if (SHARED) {
                const int b = ent >> 13; float* xp = a.out + (size_t)ent * 1024 + nh * 512 + wn * 128 + 4 * fq; const float* gp = mod + b * 6144 + 5120 + nh * 512 + wn * 128 + 4 * fq;
#pragma unroll
                for (int n = 0; n < 8; ++n) { const f32x4 x1 = *(const f32x4*)(xp + 16 * n), gt = *(const f32x4*)(gp + 16 * n);
                    *(f32x4*)(xp + 16 * n) = x1 * DN_ALPHA + (gt + 1.0f) * acc[m][n]; if (n & 1) asm volatile("" ::: "memory"); }
            } else if (ent >= 0) {
                const float w = sW[row]; bf16* yp = Y + (size_t)ent * 1024 + nh * 512 + wn * 128 + 4 * fq;
#pragma unroll
                for (int n = 0; n < 8; ++n) { const f32x4 v = acc[m][n] * w; u32x2 o; o.x = pk2(v.x, v.y); o.y = pk2(v.z, v.w); *(u32x2*)(yp + 16 * n) = o; }
            }
        }
    }
#else
    {
        const bf16* arow[4];
#pragma unroll
        for (int m = 0; m < 4; ++m) { int ent = sEnt[wm * 64 + 16 * m + fr]; if (ent < 0) ent = -1 - ent; const int tokr = SHARED ? ent : (ent >> 3); arow[m] = h2 + (size_t)tokr * 1024; }
        const bf16* Wgb = Wg + (size_t)(wn * 64 + 4 * fq) * 1024; const bf16* Wub = Wu + (size_t)(wn * 64 + 4 * fq) * 1024;
#pragma unroll 1
        for (int nq = 0; nq < 4; ++nq) {
            f32x4 acc[4][2];
            core_naive<2>([&](int m, int k8) { return *(const u32x4*)(arow[m] + 8 * k8); },
                          [&](int n, int r, int k8) { const bf16* base = (n == 0) ? Wgb : Wub; return *(const u32x4*)(base + (size_t)(16 * nq + r) * 1024 + 8 * k8); }, 1024, acc);
#pragma unroll
            for (int m = 0; m < 4; ++m) { const f32x4 g = acc[m][0], u = acc[m][1];
                st_elem4<32>(HT, wm * 64 + 16 * m + fr, wn * 64 + 16 * nq + 4 * fq, silu_f(g.x) * u.x, silu_f(g.y) * u.y, silu_f(g.z) * u.z, silu_f(g.w) * u.w); }
        }
    }
    __syncthreads();
#pragma unroll 1
    for (int nh = 0; nh < 8; ++nh) {
        f32x4 acc[4][2];
        const bf16* Wdb = Wd + (size_t)(nh * 128 + wn * 32 + 4 * fq) * 256;
        core_naive<2>([&](int m, int k8) { return ld_chunk<32>(HT, wm * 64 + 16 * m + fr, k8); },
                      [&](int n, int r, int k8) { return *(const u32x4*)(Wdb + (size_t)(16 * n + r) * 256 + 8 * k8); }, 256, acc);
#pragma unroll
        for (int m = 0; m < 4; ++m) {
            const int row = wm * 64 + 16 * m + fr; const int ent = sEnt[row];
            if (SHARED) {
                const int b = ent >> 13; float* xp = a.out + (size_t)ent * 1024 + nh * 128 + wn * 32 + 4 * fq; const float* gp = mod + b * 6144 + 5120 + nh * 128 + wn * 32 + 4 * fq;
#pragma unroll
                for (int n = 0; n < 2; ++n) { const f32x4 x1 = *(const f32x4*)(xp + 16 * n), gt = *(const f32x4*)(gp + 16 * n);
                    *(f32x4*)(xp + 16 * n) = x1 * DN_ALPHA + (gt + 1.0f) * acc[m][n]; }
            } else if (ent >= 0) {
                const float w = sW[row]; bf16* yp = Y + (size_t)ent * 1024 + nh * 128 + wn * 32 + 4 * fq;
#pragma unroll
                for (int n = 0; n < 2; ++n) { const f32x4 v = acc[m][n] * w; u32x2 o; o.x = pk2(v.x, v.y); o.y = pk2(v.z, v.w); *(u32x2*)(yp + 16 * n) = o; }
            }
        }
    }
#endif
}
__device__ __forceinline__ void phase_moe(const Args& a, LAS unsigned char* lds, int tid, int lane, int wave, int vcu, int G) {
    unsigned char* ws = a.ws;
    const unsigned* cnt = (const unsigned*)(ws + WS_CTL); const int* list = (const int*)(ws + WS_LIST); const float* topw = (const float*)(ws + WS_TOPW);
    LAS unsigned char* HT = lds + 81920;
    LAS int* pre = (LAS int*)(lds + 147456);
    LAS int* sEnt = (LAS int*)(lds + 147456 + 2048);
    LAS float* sW = (LAS float*)(lds + 147456 + 2048 + 512);
    if (tid == 0) { int s = 0; for (int e = 0; e < NE; ++e) { pre[e] = s; s += (int)((cnt[e] + 127u) >> 7); } pre[NE] = s; }
    __syncthreads();
    const int nrouted = pre[NE], nitems = nrouted + T / 128;
    for (int it = vcu; it < nitems; it += G) {
        __syncthreads();
        if (it >= nrouted) {
            if (tid < 128) { sEnt[tid] = (it - nrouted) * 128 + tid; sW[tid] = 1.f; }
            __syncthreads();
            moe_item<true>(a, lds, HT, sEnt, sW, (const bf16*)(ws + WS_WSG), (const bf16*)(ws + WS_WSU), (const bf16*)(ws + WS_WSD), tid, lane, wave);
        } else {
            int lo = 0, hi = NE - 1; while (lo < hi) { const int mid = (lo + hi + 1) >> 1; if (pre[mid] <= it) lo = mid; else hi = mid - 1; }
            const int e = lo, rb = it - pre[e];
            if (tid < 128) { const int n_e = (int)cnt[e], li = rb * 128 + tid; const bool valid = li < n_e; const int ent = list[(size_t)e * 32768 + (valid ? li : rb * 128)];
                sEnt[tid] = valid ? ent : -1 - ent; sW[tid] = valid ? topw[ent] : 0.f; }
            __syncthreads();
            moe_item<false>(a, lds, HT, sEnt, sW, (const bf16*)(ws + WS_WEG) + (size_t)e * 262144, (const bf16*)(ws + WS_WEU) + (size_t)e * 262144, (const bf16*)(ws + WS_WED) + (size_t)e * 262144, tid, lane, wave);
        }
    }
}

__device__ __forceinline__ void phase_final(const Args& a, int lane, int gw, int NGW) {
    const float* mod = (const float*)(a.ws + WS_MOD); const bf16* Y = (const bf16*)(a.ws + WS_Y);
    for (int row = gw; row < T; row += NGW) {
        const int b = row >> 13;
        f32x4* xr = (f32x4*)(a.out + (size_t)row * D) + lane;
        f32x4 v[4]; float s = 0.f;
#pragma unroll
        for (int j = 0; j < 4; ++j) { const int col = 4 * lane + 256 * j; f32x4 r = {0.f, 0.f, 0.f, 0.f};
#pragma unroll
            for (int k = 0; k < TOPK; ++k) { const u32x2 m = *((const u32x2*)(Y + ((size_t)row * 8 + k) * 1024) + lane + 64 * j);
                r += (f32x4){bf2f(m.x & 0xffffu), bf2f(m.x >> 16), bf2f(m.y & 0xffffu), bf2f(m.y >> 16)}; }
            const f32x4 gt = *(const f32x4*)(mod + b * 6144 + 5120 + col);
            v[j] = xr[64 * j] + (gt + 1.0f) * r; s += (v[j].x + v[j].y) + (v[j].z + v[j].w); }
        const float mean = wave_sum(s) * (1.f / D); float s2 = 0.f;
#pragma unroll
        for (int j = 0; j < 4; ++j) { v[j] = v[j] - mean; s2 += (v[j].x * v[j].x + v[j].y * v[j].y) + (v[j].z * v[j].z + v[j].w * v[j].w); }
        const float rstd = 1.f / sqrtf(wave_sum(s2) * (1.f / D) + LN_EPS);
#pragma unroll
        for (int j = 0; j < 4; ++j) { const int col = 4 * lane + 256 * j; xr[64 * j] = v[j] * rstd * *(const f32x4*)(a.in[29] + col) + *(const f32x4*)(a.in[30] + col); }
    }
}

#define XB_TMO      128
#define XB_XCNT(j)  (256  + 64 * (j))
#define XB_XSUB(j)  (1280 + 64 * (j))
#define XB_XGEN(j)  (2304 + 64 * (j))
#define XB_TOP      3328
#define XB_TOPGEN   3392
#define XCD_BAR_WORDS 3456
#define XB_SPIN_CAP (1u << 20)
constexpr int CW_BAR = 4096;
__device__ __forceinline__ unsigned xb_ld(unsigned* p)              { return __hip_atomic_load(p, __ATOMIC_RELAXED, __HIP_MEMORY_SCOPE_AGENT); }
__device__ __forceinline__ unsigned xb_add(unsigned* p, unsigned v) { return __hip_atomic_fetch_add(p, v, __ATOMIC_RELAXED, __HIP_MEMORY_SCOPE_AGENT); }
__device__ __forceinline__ unsigned xb_xcc_id() { return (unsigned)__builtin_amdgcn_s_getreg((3 << 11) | 20) & 0xFu; }
#define XB_SPIN(cond, bar) do { unsigned _sp = 0; while (cond) { __builtin_amdgcn_s_sleep(1); \
    if ((++_sp & 255u) == 0u) { if (xb_ld(&(bar)[XB_TMO])) break; if (_sp > XB_SPIN_CAP) { atomicAdd(&(bar)[XB_TMO], 1u); break; } } } } while (0)
struct XcdBarrier { unsigned* bar; unsigned x; volatile LAS unsigned* st; };
__device__ __forceinline__ XcdBarrier xcd_barrier_post(unsigned* bar, volatile LAS unsigned* st) {
    XcdBarrier b; b.bar = bar; b.x = xb_xcc_id(); b.st = st;
    if (threadIdx.x == 0) (void)xb_add(&bar[XB_XCNT(b.x)], 1u);
    return b;
}
__device__ __forceinline__ void xcd_barrier_complete(unsigned* bar, unsigned x, unsigned& nloc, unsigned& nx) {
    const unsigned G = gridDim.x * gridDim.y * gridDim.z;
    unsigned sum, cnt, mine, sp = 0u;
    for (;;) {
        sum = 0u; cnt = 0u; mine = 0u;
#pragma unroll
        for (unsigned j = 0; j < 16; ++j) { const unsigned c = xb_ld(&bar[XB_XCNT(j)]); sum += c; cnt += (c > 0u) ? 1u : 0u; mine = (j == x) ? c : mine; }
        if (sum == G) break;
        __builtin_amdgcn_s_sleep(1);
        if ((++sp & 255u) == 0u) { if (xb_ld(&bar[XB_TMO])) break; if (sp > XB_SPIN_CAP) { atomicAdd(&bar[XB_TMO], 1u); break; } }
    }
    nloc = mine > 0u ? mine : 1u; nx = cnt > 0u ? cnt : 1u;
}
__device__ __forceinline__ void xcd_barrier(const XcdBarrier& b) {
    asm volatile("s_waitcnt vmcnt(0)" ::: "memory");
    __syncthreads();
    if (threadIdx.x == 0) {
        unsigned* bar = b.bar;
        __builtin_amdgcn_s_waitcnt(0);
        unsigned nloc = b.st[0], nx = b.st[1];
        if (nloc == 0u) { xcd_barrier_complete(bar, b.x, nloc, nx); b.st[0] = nloc; b.st[1] = nx; }
        const unsigned old = xb_add(&bar[XB_XSUB(b.x)], 1u);
        const unsigned gen = old / nloc;
        if (old + 1u == (gen + 1u) * nloc) {
            __builtin_amdgcn_fence(__ATOMIC_RELEASE, "agent");
            asm volatile("s_waitcnt vmcnt(0)" ::: "memory");
            const unsigned og = xb_add(&bar[XB_TOP], 1u);
            const unsigned tg = og / nx;
            if (og + 1u == (tg + 1u) * nx) xb_add(&bar[XB_TOPGEN], 1u);
            else XB_SPIN(xb_ld(&bar[XB_TOPGEN]) == tg, bar);
            __builtin_amdgcn_fence(__ATOMIC_ACQUIRE, "agent");
            xb_add(&bar[XB_XGEN(b.x)], 1u);
            asm volatile("s_waitcnt vmcnt(0)" ::: "memory");
        } else {
            XB_SPIN(xb_ld(&bar[XB_XGEN(b.x)]) == gen, bar);
            __builtin_amdgcn_fence(__ATOMIC_ACQUIRE, "agent");
            asm volatile("s_waitcnt vmcnt(0)" ::: "memory");
        }
    }
    __syncthreads();
}

constexpr int LDS_BAR_OFF = LDS_BYTES - 64;
__global__ void __launch_bounds__(NTHREADS, 2) mk_fwd(Args a) {
    extern __shared__ __attribute__((aligned(16))) unsigned char lds_raw[];
    LAS unsigned char* lds = (LAS unsigned char*)lds_raw;
    const int tid = threadIdx.x, lane = tid & 63, wave = __builtin_amdgcn_readfirstlane(tid >> 6);
    const int G = gridDim.x, bx = blockIdx.x, vcu = (G % 8 == 0) ? (bx % 8) * (G / 8) + bx / 8 : bx;
    const int gw = vcu * NWAVES + wave, NGW = G * NWAVES;
    unsigned char* ws = a.ws;
    if (tid < 16) ((LAS unsigned*)(lds + LDS_BAR_OFF))[tid] = 0u;
    __syncthreads();
    const XcdBarrier bar = xcd_barrier_post((unsigned*)(ws + WS_CTL) + CW_BAR, (volatile LAS unsigned*)(lds + LDS_BAR_OFF));
    const int lo = a.ph_lo, hi = a.ph_hi;
#define IN(k) (lo <= (k) && (k) < hi && PHEN(k))
#define SEAM(k) do { if (IN(k) && IN((k) + 1)) xcd_barrier(bar); } while (0)
    if (IN(0)) phase_prep(a, lds, tid, lane, wave, vcu, G);
    SEAM(0);
    if (IN(1)) phase_ln1(a, lane, gw, NGW);
    SEAM(1);
    if (IN(2)) { bf16* proj = (bf16*)(ws + WS_PROJ);
        phase_gemm_dense((const bf16*)(ws + WS_HB), (const bf16*)(ws + WS_WIN), T, 2048, 1024, lds, tid, lane, wave, vcu, G,
            [&](int row, int col, f32x4 v) { u32x2 o; o.x = pk2(v.x, v.y); o.y = pk2(v.z, v.w); *(u32x2*)(proj + (size_t)row * 2048 + col) = o; }); }
    SEAM(2);
    if (IN(3)) phase_conv_gates(a, lane, gw, NGW);
    SEAM(3);
    if (IN(4)) phase_mlstm_local(a, lds, tid, vcu, G);
    SEAM(4);
    if (IN(5)) phase_scan(a, tid, vcu, G);
    SEAM(5);
    if (IN(6)) phase_mixer_out(a, lds, tid, vcu, G);
    SEAM(6);
    if (IN(7)) { bf16* mixo = (bf16*)(ws + WS_MIXO);
        phase_gemm_dense((const bf16*)(ws + WS_MIX), (const bf16*)(ws + WS_WOUT), T, 1024, 1024, lds, tid, lane, wave, vcu, G,
            [&](int row, int col, f32x4 v) { u32x2 o; o.x = pk2(v.x, v.y); o.y = pk2(v.z, v.w); *(u32x2*)(mixo + (size_t)row * 1024 + col) = o; }); }
    SEAM(7);
    if (IN(8)) phase_ln2(a, lane, gw, NGW);
    SEAM(8);
    if (IN(9)) { float* lg = (float*)(ws + WS_LOG);
        phase_gemm_dense((const bf16*)(ws + WS_H2), (const bf16*)(ws + WS_WR), T, 256, 1024, lds, tid, lane, wave, vcu, G,
            [&](int row, int col, f32x4 v) { *(f32x4*)(lg + (size_t)row * 256 + col) = v; }); }
    SEAM(9);
    if (IN(10)) phase_route(a, lane, gw, NGW);
    SEAM(10);
    if (IN(11)) phase_moe(a, lds, tid, lane, wave, vcu, G);
    SEAM(11);
    if (IN(12)) phase_final(a, lane, gw, NGW);
#undef IN
#undef SEAM
}

extern "C" void kernel_launch(void* const* d_in, const int* in_sizes, int n_in, void* d_out, int out_size, void* d_ws, size_t ws_size, hipStream_t stream) {
    static int grid = 0;
    if (grid == 0) {
        if (n_in != 31 || out_size != T * D || ws_size < WS_END) { fprintf(stderr, "kernel_launch: unexpected problem (n_in %d out %d ws %zu)\n", n_in, out_size, ws_size); grid = -1; return; }
        int dev = 0, cus = 0, per_cu = 0;
        if (hipGetDevice(&dev) != hipSuccess || hipDeviceGetAttribute(&cus, hipDeviceAttributeMultiprocessorCount, dev) != hipSuccess) { grid = -1; return; }
        if (hipFuncSetAttribute((const void*)mk_fwd, hipFuncAttributeMaxDynamicSharedMemorySize, LDS_BYTES) != hipSuccess) { fprintf(stderr, "kernel_launch: hipFuncSetAttribute failed\n"); grid = -1; return; }
        if (hipOccupancyMaxActiveBlocksPerMultiprocessor(&per_cu, (const void*)mk_fwd, NTHREADS, LDS_BYTES) != hipSuccess || per_cu < 1) fprintf(stderr, "kernel_launch: occupancy query reports %d\n", per_cu);
        (void)hipGetLastError();
        grid = cus;
    }
    if (grid < 0) return;
    (void)hipMemsetAsync((char*)d_ws + WS_CTL, 0, CTL_BYTES, stream);
    Args a{};
    for (int i = 0; i < 31; ++i) a.in[i] = (const float*)d_in[i];
    a.out = (float*)d_out; a.ws = (unsigned char*)d_ws; a.ph_lo = 0; a.ph_hi = NPHASE;
    hipLaunchKernelGGL(mk_fwd, dim3(grid), dim3(NTHREADS), LDS_BYTES, stream, a);
}
```

```cpp
#include <hip/hip_runtime.h>
#include <cstdio>
#include <cstdint>

#ifndef USE_MFMA
#define USE_MFMA 1
#endif

#ifndef ONLYPH
#define ONLYPH -1
#endif
#define PHEN(k) (ONLYPH < 0 || ONLYPH == (k))
#ifndef PROBE_MASK
#define PROBE_MASK 0
#endif
#define REPK(k) (((PROBE_MASK >> (k)) & 1) ? 2 : 1)
#define LAS __attribute__((address_space(3)))
typedef unsigned short bf16;
typedef float f32x4 __attribute__((ext_vector_type(4)));
typedef short bf16x8 __attribute__((ext_vector_type(8)));
typedef unsigned u32x4 __attribute__((ext_vector_type(4)));
typedef unsigned u32x2 __attribute__((ext_vector_type(2)));

constexpr int NB = 4, SEQ = 8192, T = NB * SEQ, D = 1024;
constexpr int NH = 4, DH = 128, LCH = 128, NCH = SEQ / LCH;
constexpr int NE = 256, TOPK = 8, DE = 256;
constexpr float LN_EPS = 1e-5f, DN_ALPHA = 1.189207115002721f, ROUTE_SCALE = 2.5f, KSCALE = 0.08838834764831845f;
constexpr int NPHASE = 13;
constexpr int NTHREADS = 512, NWAVES = 8;
constexpr int LDS_BYTES = 155648;

constexpr size_t MiB = (size_t)1 << 20;
constexpr size_t WS_CTL = 0, CTL_BYTES = 1 * MiB;
constexpr size_t WS_MOD = 1 * MiB;
constexpr size_t WS_WG = 1 * MiB + 128 * 1024;
constexpr size_t WS_WIN = 2 * MiB;
constexpr size_t WS_WOUT = 6 * MiB;
constexpr size_t WS_WQKV = 8 * MiB;
constexpr size_t WS_WR = 9 * MiB;
constexpr size_t WS_WSP = 9 * MiB + 512 * 1024;
constexpr size_t WS_WSG = 10 * MiB;
constexpr size_t WS_WSU = 10 * MiB + 512 * 1024;
constexpr size_t WS_WSD = 11 * MiB;
constexpr size_t WS_WEG = 12 * MiB;
constexpr size_t WS_WEU = 140 * MiB;
constexpr size_t WS_WED = 268 * MiB;
constexpr size_t WS_H2 = 396 * MiB;
constexpr size_t WS_TOPI = 460 * MiB;
constexpr size_t WS_TOPW = 461 * MiB;
constexpr size_t WS_LIST = 462 * MiB;
constexpr size_t WS_LOG = 494 * MiB;
constexpr size_t WS_Y = 512 * MiB;
constexpr size_t WS_HB = 528 * MiB;
constexpr size_t WS_PROJ = 592 * MiB;
constexpr size_t WS_XC = 720 * MiB;
constexpr size_t WS_GATES = 752 * MiB;
constexpr size_t WS_QB = 754 * MiB;
constexpr size_t WS_CLOC = 786 * MiB;
constexpr size_t WS_NUML = 850 * MiB;
constexpr size_t WS_BCUM = 914 * MiB;
constexpr size_t WS_MLOC = 914 * MiB + 512 * 1024;
constexpr size_t WS_DEN = 915 * MiB;
constexpr size_t WS_GCH = 916 * MiB;
constexpr size_t WS_MLS = 916 * MiB + 4096;
constexpr size_t WS_MPREV = 916 * MiB + 8192;
constexpr size_t WS_NLOC = 916 * MiB + 512 * 1024;
constexpr size_t WS_NPREV = 917 * MiB;
constexpr size_t WS_CPREV = 918 * MiB;
constexpr size_t WS_MIX = 950 * MiB;
constexpr size_t WS_MIXO = WS_HB;
constexpr size_t WS_END = 1024 * MiB;

struct Args { const float* in[31]; float* out; unsigned char* ws; int ph_lo, ph_hi; };

__device__ __forceinline__ float bf2f(unsigned v) { return __uint_as_float(v << 16); }
__device__ __forceinline__ unsigned f2bf(float f) { unsigned u = __float_as_uint(f); return (u + 0x7fffu + ((u >> 16) & 1u)) >> 16; }
__device__ __forceinline__ unsigned pk2(float lo, float hi) { return f2bf(lo) | (f2bf(hi) << 16); }
__device__ __forceinline__ float rbf(float f) { return bf2f(f2bf(f)); }
__device__ __forceinline__ void unpack8(const u32x4 v, float (&o)[8]) {
    o[0] = __uint_as_float(v.x << 16); o[1] = __uint_as_float(v.x & 0xffff0000u);
    o[2] = __uint_as_float(v.y << 16); o[3] = __uint_as_float(v.y & 0xffff0000u);
    o[4] = __uint_as_float(v.z << 16); o[5] = __uint_as_float(v.z & 0xffff0000u);
    o[6] = __uint_as_float(v.w << 16); o[7] = __uint_as_float(v.w & 0xffff0000u);
}
__device__ __forceinline__ float wave_sum(float v) {
#pragma unroll
    for (int o = 1; o < 64; o <<= 1) v += __shfl_xor(v, o);
    return v;
}
__device__ __forceinline__ float wave_max(float v) {
#pragma unroll
    for (int o = 1; o < 64; o <<= 1) v = fmaxf(v, __shfl_xor(v, o));
    return v;
}
__device__ __forceinline__ float sigmoid_f(float x) { return 1.0f / (1.0f + __expf(-x)); }
__device__ __forceinline__ float silu_f(float x) { return x / (1.0f + __expf(-x)); }
__device__ __forceinline__ float gelu_f(float x) { return 0.5f * x * (1.0f + erff(x * 0.7071067811865476f)); }
__device__ __forceinline__ float logsigmoid_f(float x) { return fminf(x, 0.f) - log1pf(__expf(-fabsf(x))); }
#define LDS_WAIT() asm volatile("s_waitcnt lgkmcnt(0)" ::: "memory")

template <int CH> __device__ __forceinline__ int toff(int row, int chunk) {
    const int s = (CH == 4) ? ((row >> 1) & 3) : (CH == 8) ? (row & 7) : (row & 15);
    return row * (CH * 16) + ((chunk ^ s) << 4);
}
template <int CH> __device__ __forceinline__ u32x4 ld_chunk(const LAS unsigned char* tile, int row, int chunk) { return *(const LAS u32x4*)(tile + toff<CH>(row, chunk)); }
template <int CH> __device__ __forceinline__ void st_chunk(LAS unsigned char* tile, int row, int chunk, u32x4 v) { *(LAS u32x4*)(tile + toff<CH>(row, chunk)) = v; }
template <int CH> __device__ __forceinline__ float ld_elem(const LAS unsigned char* tile, int row, int col) { return bf2f(*(const LAS unsigned short*)(tile + toff<CH>(row, col >> 3) + (col & 7) * 2)); }
template <int CH> __device__ __forceinline__ void st_elem4(LAS unsigned char* tile, int row, int col  , float a, float b, float c, float d) {
    u32x2 v; v.x = pk2(a, b); v.y = pk2(c, d); *(LAS u32x2*)(tile + toff<CH>(row, col >> 3) + (col & 7) * 2) = v;
}
__device__ __forceinline__ float dot8(const float (&a)[8], const float (&b)[8], float acc) {
#pragma unroll
    for (int i = 0; i < 8; ++i) acc = fmaf(a[i], b[i], acc);
    return acc;
}

template <int NN, class FA, class FB>
__device__ __forceinline__ void core_naive(FA fa, FB fb, int K, f32x4 (&acc)[4][NN]) {
#pragma unroll
    for (int m = 0; m < 4; ++m)
#pragma unroll
        for (int n = 0; n < NN; ++n) acc[m][n] = (f32x4){0.f, 0.f, 0.f, 0.f};
    for (int k8 = 0; k8 < K / 8; ++k8) {
        float af[4][8];
#pragma unroll
        for (int m = 0; m < 4; ++m) unpack8(fa(m, k8), af[m]);
#pragma unroll
        for (int n = 0; n < NN; ++n)
#pragma unroll
            for (int r = 0; r < 4; ++r) {
                float bf[8]; unpack8(fb(n, r, k8), bf);
#pragma unroll
                for (int m = 0; m < 4; ++m) acc[m][n][r] = dot8(af[m], bf, acc[m][n][r]);
                asm volatile("" ::: "memory");
            }
    }
}

typedef __attribute__((address_space(1))) const unsigned gcu32;
template <int WM, int WN, int BK, bool A_LDS, int A_CH, class RA, class RB>
__device__ __forceinline__ void core_mfma(LAS unsigned char* stg, const LAS unsigned char* At, RA rowA, RB rowB, int K, f32x4 (&acc)[4][8], int tid, int lane, int wave) {
    constexpr int CH = BK / 8, RA_ROWS = A_LDS ? 0 : 64 * WM, RB_ROWS = 128 * WN;
    constexpr int NCHUNK = (RA_ROWS + RB_ROWS) * CH, NI = NCHUNK / 512, STAGE = NCHUNK * 16, A_BYTES = RA_ROWS * CH * 16, NIA = RA_ROWS * CH / 512;
    static_assert(NCHUNK % 512 == 0 && (RA_ROWS * CH) % 512 == 0, "tile chunks must split evenly over 512 threads");
    asm volatile("" : "+v"(tid));
    lane = tid & 63;
    const int wm = wave / WN, wn = wave % WN, fr = lane & 15, fq = lane >> 4;
    const bf16* src[NI];
#pragma unroll
    for (int i = 0; i < NI; ++i) {
        const int p = i * 512 + tid;
        if (i < NIA) { const int row = p / CH, cp = p % CH; const int s = (CH == 4) ? ((row >> 1) & 3) : (row & 7); src[i] = rowA(row) + ((cp ^ s) << 3); }
        else { const int q = p - RA_ROWS * CH, row = q / CH, cp = q % CH; const int s = (CH == 4) ? ((row >> 1) & 3) : (row & 7); src[i] = rowB(row) + ((cp ^ s) << 3); }
    }
#pragma unroll
    for (int m = 0; m < 4; ++m)
#pragma unroll
        for (int n = 0; n < 8; ++n) acc[m][n] = (f32x4){0.f, 0.f, 0.f, 0.f};
    const int nk = K / BK;
#define CM_ISSUE(s_, kt_) do { _Pragma("unroll") for (int i_ = 0; i_ < NI; ++i_) \
        __builtin_amdgcn_global_load_lds((gcu32*)(src[i_] + (kt_) * BK), (LAS unsigned*)(stg + (s_) * STAGE + (i_ * 512 + wave * 64) * 16), 16, 0, 0); } while (0)
    CM_ISSUE(0, 0);
    asm volatile("s_waitcnt vmcnt(0)" ::: "memory");
    __syncthreads();
    for (int kt = 0; kt < nk; ++kt) {
        const int s = kt & 1;
        if (kt + 1 < nk) CM_ISSUE(s ^ 1, kt + 1);
        const LAS unsigned char* As = A_LDS ? At : (const LAS unsigned char*)(stg + s * STAGE);
        const LAS unsigned char* Bs = stg + s * STAGE + A_BYTES;
#pragma unroll
        for (int kk = 0; kk < BK / 32; ++kk) {
            bf16x8 af[4], bfr[8];
#pragma unroll
            for (int m = 0; m < 4; ++m) {
                const int row = wm * 64 + 16 * m + fr;
                if (A_LDS) af[m] = *(const LAS bf16x8*)(As + toff<A_CH>(row, kt * CH + kk * 4 + fq));
                else af[m] = *(const LAS bf16x8*)(As + toff<CH>(row, kk * 4 + fq));
            }
#pragma unroll
            for (int n = 0; n < 8; ++n) bfr[n] = *(const LAS bf16x8*)(Bs + toff<CH>(wn * 128 + 16 * n + fr, kk * 4 + fq));
#pragma unroll
            for (int m = 0; m < 4; ++m)
#pragma unroll
                for (int n = 0; n < 8; ++n) acc[m][n] = __builtin_amdgcn_mfma_f32_16x16x32_bf16(bfr[n], af[m], acc[m][n], 0, 0, 0);
        }
        asm volatile("s_waitcnt vmcnt(0)" ::: "memory");
        __syncthreads();
    }
#undef CM_ISSUE
}

__device__ __forceinline__ void transpose_item(const float* W, int K, int N, bf16* WT, float scale, int item, int lane, LAS float* scr) {
    const int nblk = N / 32, kb = item / nblk, nb = item % nblk, k0 = 64 * kb, n0 = 32 * nb;
#pragma unroll 8
    for (int i = 0; i < 32; ++i) { const int kk = 2 * i + (lane >> 5); scr[kk * 33 + (lane & 31)] = W[(size_t)(k0 + kk) * N + n0 + (lane & 31)]; }
    LDS_WAIT();
    const int c = lane & 7;
#pragma unroll
    for (int j = 0; j < 4; ++j) {
        const int n = (lane >> 3) + 8 * j; const LAS float* s = scr + (8 * c) * 33 + n;
        u32x4 o; o.x = pk2(s[0 * 33] * scale, s[1 * 33] * scale); o.y = pk2(s[2 * 33] * scale, s[3 * 33] * scale);
        o.z = pk2(s[4 * 33] * scale, s[5 * 33] * scale); o.w = pk2(s[6 * 33] * scale, s[7 * 33] * scale);
        *(u32x4*)(WT + (size_t)(n0 + n) * K + k0 + 8 * c) = o;
    }
    LDS_WAIT();
}

__device__ __forceinline__ void phase_prep(const Args& a, LAS unsigned char* lds, int tid, int lane, int wave, int vcu, int G) {
    unsigned char* ws = a.ws;
    {
        LAS float* scr = (LAS float*)(lds + wave * 16384);
        const int gw = vcu * NWAVES + wave, NGW = G * NWAVES;
        constexpr int NITEMS = 1024 + 512 + 96 + 128 + 384 + 3 * 32768;
        for (int it = gw; it < NITEMS; it += NGW) {
            int r = it;
            if (r < 1024) { transpose_item(a.in[4], 1024, 2048, (bf16*)(ws + WS_WIN), 1.f, r, lane, scr); continue; } r -= 1024;
            if (r < 512) { transpose_item(a.in[18], 1024, 1024, (bf16*)(ws + WS_WOUT), 1.f, r, lane, scr); continue; } r -= 512;
            if (r < 96) { const int which = r / 32, rr = r % 32, h = rr / 8, ii = rr % 8;
                const float* src = (which == 0 ? a.in[7] : which == 1 ? a.in[8] : a.in[9]) + h * 16384;
                transpose_item(src, 128, 128, (bf16*)(ws + WS_WQKV) + (which * 4 + h) * 16384, which == 1 ? KSCALE : 1.f, ii, lane, scr); continue; } r -= 96;
            if (r < 128) { transpose_item(a.in[21], 1024, 256, (bf16*)(ws + WS_WR), 1.f, r, lane, scr); continue; } r -= 128;
            if (r < 128) { transpose_item(a.in[26], 1024, 256, (bf16*)(ws + WS_WSG), 1.f, r, lane, scr); continue; } r -= 128;
            if (r < 128) { transpose_item(a.in[27], 1024, 256, (bf16*)(ws + WS_WSU), 1.f, r, lane, scr); continue; } r -= 128;
            if (r < 128) { transpose_item(a.in[28], 256, 1024, (bf16*)(ws + WS_WSD), 1.f, r, lane, scr); continue; } r -= 128;
            if (r < 32768) { const int e = r >> 7; transpose_item(a.in[23] + (size_t)e * 262144, 1024, 256, (bf16*)(ws + WS_WEG) + (size_t)e * 262144, 1.f, r & 127, lane, scr); continue; } r -= 32768;
            if (r < 32768) { const int e = r >> 7; transpose_item(a.in[24] + (size_t)e * 262144, 1024, 256, (bf16*)(ws + WS_WEU) + (size_t)e * 262144, 1.f, r & 127, lane, scr); continue; } r -= 32768;
            { const int e = r >> 7; transpose_item(a.in[25] + (size_t)e * 262144, 256, 1024, (bf16*)(ws + WS_WED) + (size_t)e * 262144, 1.f, r & 127, lane, scr); }
        }
    }
    __syncthreads();
    {
        LAS float* sc = (LAS float*)lds;
        LAS float* part = (LAS float*)(lds + 16384);
        for (int it = vcu; it < 96; it += G) {
            __syncthreads();
            for (int i = tid; i < 4096; i += NTHREADS) sc[i] = silu_f(a.in[1][i]);
            __syncthreads();
            const int col = it * 64 + lane;
            float s0 = 0.f, s1 = 0.f, s2 = 0.f, s3 = 0.f;
            const float* wp = a.in[2] + (size_t)(wave * 128) * 6144 + col;
#pragma unroll 8
            for (int k = 0; k < 128; ++k) { const float w = wp[(size_t)k * 6144]; const int kk = wave * 128 + k;
                s0 = fmaf(sc[kk], w, s0); s1 = fmaf(sc[1024 + kk], w, s1); s2 = fmaf(sc[2048 + kk], w, s2); s3 = fmaf(sc[3072 + kk], w, s3); }
            part[(wave * 4 + 0) * 64 + lane] = s0; part[(wave * 4 + 1) * 64 + lane] = s1; part[(wave * 4 + 2) * 64 + lane] = s2; part[(wave * 4 + 3) * 64 + lane] = s3;
            __syncthreads();
            if (tid < 256) { const int b = tid >> 6, cl = tid & 63; float s = a.in[3][it * 64 + cl];
#pragma unroll
                for (int w = 0; w < 8; ++w) s += part[(w * 4 + b) * 64 + cl];
                ((float*)(ws + WS_MOD))[b * 6144 + it * 64 + cl] = s; }
        }
        __syncthreads();
    }
    {
        const int gt = vcu * NTHREADS + tid, NGT = G * NTHREADS;
        bf16* wsp = (bf16*)(ws + WS_WSP);
        for (int i = gt; i < 65536; i += NGT) { const int t = (i >> 7) & 127, s = i & 127; wsp[i] = (s <= t) ? (bf16)f2bf(a.in[16][i]) : (bf16)0; }
        float* wg = (float*)(ws + WS_WG);
        const float* wq = a.in[7]; const float* wk = a.in[8]; const float* wv = a.in[9]; const float* wif = a.in[10];
        for (int i = gt; i < 8192; i += NGT) {
            const int row = i >> 3, j = i & 7; float s = 0.f;
            if (row < 512) { const int h = row >> 7, d = row & 127; float sq = 0.f, sk = 0.f;
                for (int e = 0; e < 128; ++e) { sq = fmaf(wq[(h * 128 + d) * 128 + e], wif[(h * 128 + e) * 8 + j], sq); sk = fmaf(wk[(h * 128 + d) * 128 + e], wif[(512 + h * 128 + e) * 8 + j], sk); }
                s = sq + KSCALE * sk; }
            else { const int ch = row - 512, h = ch >> 7, d = ch & 127;
                for (int e = 0; e < 128; ++e) s = fmaf(wv[(h * 128 + d) * 128 + e], wif[(1024 + h * 128 + e) * 8 + j], s); }
            wg[i] = s;
        }
    }
}

__device__ __forceinline__ void phase_ln1(const Args& a, int lane, int gw, int NGW) {
    const float* mod = (const float*)(a.ws + WS_MOD); bf16* hb = (bf16*)(a.ws + WS_HB);
    for (int row = gw; row < T; row += NGW) {
        const int b = row >> 13;
        const f32x4* xr = (const f32x4*)(a.in[0] + (size_t)row * D) + lane;
        f32x4 v[4]; float s = 0.f;
#pragma unroll
        for (int j = 0; j < 4; ++j) { v[j] = xr[64 * j]; s += (v[j].x + v[j].y) + (v[j].z + v[j].w); }
        const float mean = wave_sum(s) * (1.f / D); float s2 = 0.f;
#pragma unroll
        for (int j = 0; j < 4; ++j) { v[j] = v[j] - mean; s2 += (v[j].x * v[j].x + v[j].y * v[j].y) + (v[j].z * v[j].z + v[j].w * v[j].w); }
        const float rstd = 1.f / sqrtf(wave_sum(s2) * (1.f / D) + LN_EPS);
        u32x2* o8 = (u32x2*)(hb + (size_t)row * D) + lane;
#pragma unroll
        for (int j = 0; j < 4; ++j) { const int col = 4 * lane + 256 * j;
            const f32x4 sh = *(const f32x4*)(mod + b * 6144 + col), sc = *(const f32x4*)(mod + b * 6144 + 1024 + col);
            const f32x4 h = v[j] * rstd * (sc + 1.0f) + sh; u32x2 w; w.x = pk2(h.x, h.y); w.y = pk2(h.z, h.w); o8[64 * j] = w; }
    }
}

template <class Epi>
__device__ __forceinline__ void phase_gemm_dense(const bf16* A, const bf16* Bt, int Mrows, int N, int K, LAS unsigned char* lds, int tid, int lane, int wave, int vcu, int G, Epi epi) {
    const int nM = Mrows / 256, nN = N / 256, wm = wave >> 1, wn = wave & 1, fr = lane & 15, fq = lane >> 4;
    for (int it = vcu; it < nM * nN; it += G) {
        const int pm = it / nN, pn = it % nN;
#if USE_MFMA
        f32x4 acc[4][8];
        const bf16* Ab = A + (size_t)(pm * 256) * K; const bf16* Bb = Bt + (size_t)(pn * 256) * K;
        core_mfma<4, 2, 64, false, 8>(lds, nullptr, [&](int r) { return Ab + (size_t)r * K; }, [&](int r) { return Bb + (size_t)r * K; }, K, acc, tid, lane, wave);
#pragma unroll
        for (int m = 0; m < 4; ++m)
#pragma unroll
            for (int n = 0; n < 8; ++n) epi(pm * 256 + wm * 64 + 16 * m + fr, pn * 256 + wn * 128 + 16 * n + 4 * fq, acc[m][n]);
#else
        const bf16* Ab = A + (size_t)(pm * 256 + wm * 64 + fr) * K;
        const bf16* Bb = Bt + (size_t)(pn * 256 + wn * 128 + 4 * fq) * K;
#pragma unroll 1
        for (int nq = 0; nq < 4; ++nq) {
            f32x4 acc[4][2];
            core_naive<2>([&](int m, int k8) { return *(const u32x4*)(Ab + (size_t)(16 * m) * K + 8 * k8); },
                          [&](int n, int r, int k8) { return *(const u32x4*)(Bb + (size_t)(16 * (2 * nq + n) + r) * K + 8 * k8); }, K, acc);
#pragma unroll
            for (int m = 0; m < 4; ++m)
#pragma unroll
                for (int n = 0; n < 2; ++n) epi(pm * 256 + wm * 64 + 16 * m + fr, pn * 256 + wn * 128 + 16 * (2 * nq + n) + 4 * fq, acc[m][n]);
        }
#endif
    }
}

__device__ __forceinline__ void phase_conv_gates(const Args& a, int lane, int gw, int NGW) {
    const bf16* proj = (const bf16*)(a.ws + WS_PROJ); bf16* xcb = (bf16*)(a.ws + WS_XC); float* gates = (float*)(a.ws + WS_GATES);
    const float* wg = (const float*)(a.ws + WS_WG); const float* cw = a.in[5]; const float* cb = a.in[6]; const float* bif = a.in[11];
    const int ch = lane * 8;
    for (int tok = gw; tok < T; tok += NGW) {
        const int ts = tok & (SEQ - 1);
        float acc[8], xm[8];
#pragma unroll
        for (int i = 0; i < 8; ++i) { acc[i] = cb[ch + i]; xm[i] = 0.f; }
#pragma unroll
        for (int j = 0; j < 4; ++j) {
            if (ts - 3 + j >= 0) {
                float v[8]; unpack8(*(const u32x4*)(proj + (size_t)(tok - 3 + j) * 2048 + ch), v);
#pragma unroll
                for (int i = 0; i < 8; ++i) { acc[i] = fmaf(cw[j * 512 + ch + i], v[i], acc[i]); if (j == 3) xm[i] = v[i]; }
            }
        }
        float xc[8];
#pragma unroll
        for (int i = 0; i < 8; ++i) xc[i] = rbf(silu_f(acc[i]));
        u32x4 o; o.x = pk2(xc[0], xc[1]); o.y = pk2(xc[2], xc[3]); o.z = pk2(xc[4], xc[5]); o.w = pk2(xc[6], xc[7]);
        *(u32x4*)(xcb + (size_t)tok * 512 + ch) = o;
        float g[8];
#pragma unroll
        for (int j = 0; j < 8; ++j) g[j] = 0.f;
#pragma unroll
        for (int i = 0; i < 8; ++i) {
            const f32x4 w1a = *(const f32x4*)(wg + (ch + i) * 8), w1b = *(const f32x4*)(wg + (ch + i) * 8 + 4);
            const f32x4 w2a = *(const f32x4*)(wg + (512 + ch + i) * 8), w2b = *(const f32x4*)(wg + (512 + ch + i) * 8 + 4);
            g[0] += xc[i] * w1a.x + xm[i] * w2a.x; g[1] += xc[i] * w1a.y + xm[i] * w2a.y; g[2] += xc[i] * w1a.z + xm[i] * w2a.z; g[3] += xc[i] * w1a.w + xm[i] * w2a.w;
            g[4] += xc[i] * w1b.x + xm[i] * w2b.x; g[5] += xc[i] * w1b.y + xm[i] * w2b.y; g[6] += xc[i] * w1b.z + xm[i] * w2b.z; g[7] += xc[i] * w1b.w + xm[i] * w2b.w;
        }
#pragma unroll
        for (int j = 0; j < 8; ++j) g[j] = wave_sum(g[j]);
        if (lane == 0) {
            f32x4 o0 = {g[0] + bif[0], g[1] + bif[1], g[2] + bif[2], g[3] + bif[3]}, o1 = {g[4] + bif[4], g[5] + bif[5], g[6] + bif[6], g[7] + bif[7]};
            *(f32x4*)(gates + (size_t)tok * 8) = o0; *(f32x4*)(gates + (size_t)tok * 8 + 4) = o1;
        }
    }
}

__device__ __forceinline__ void mm128(const LAS unsigned char* A, const LAS unsigned char* B, int lane, int wave, f32x4 (&acc)[8]) {
    const int fr = lane & 15, fq = lane >> 4;
#pragma unroll
    for (int n = 0; n < 8; ++n) acc[n] = (f32x4){0.f, 0.f, 0.f, 0.f};
#pragma unroll
    for (int kk = 0; kk < 4; ++kk) {
        const bf16x8 af = *(const LAS bf16x8*)(A + toff<16>(16 * wave + fr, kk * 4 + fq));
#pragma unroll
        for (int n = 0; n < 8; ++n) { const bf16x8 bfr = *(const LAS bf16x8*)(B + toff<16>(16 * n + fr, kk * 4 + fq)); acc[n] = __builtin_amdgcn_mfma_f32_16x16x32_bf16(bfr, af, acc[n], 0, 0, 0); }
    }
}
__device__ __forceinline__ void load_tile(LAS unsigned char* Tl, const bf16* g, int ld, int tid) {
#pragma unroll
    for (int j = 0; j < 4; ++j) { const int i = tid + 512 * j, r = i >> 4, ch = i & 15; st_chunk<16>(Tl, r, ch, *(const u32x4*)(g + (size_t)r * ld + ch * 8)); }
}
__device__ __forceinline__ void store_tile_acc(LAS unsigned char* Tl, const f32x4 (&acc)[8], int row, int fq) {
#pragma unroll
    for (int n = 0; n < 8; ++n) st_elem4<16>(Tl, row, 16 * n + 4 * fq, acc[n].x, acc[n].y, acc[n].z, acc[n].w);
}

__device__ __forceinline__ void phase_mlstm_local(const Args& a, LAS unsigned char* lds, int tid, int vcu, int G) {
    unsigned char* ws = a.ws;
    const bf16* proj = (const bf16*)(ws + WS_PROJ); const bf16* xcb = (const bf16*)(ws + WS_XC); const float* gates = (const float*)(ws + WS_GATES);
    bf16* qb = (bf16*)(ws + WS_QB); float* cloc = (float*)(ws + WS_CLOC); float* numl = (float*)(ws + WS_NUML);
    LAS unsigned char* T0 = lds; LAS unsigned char* T1 = lds + 32768; LAS unsigned char* T2 = lds + 65536; LAS unsigned char* T3 = lds + 98304;
    LAS float* F = (LAS float*)(lds + 131072);
    LAS float* ipre = F; LAS float* bcum = F + 128; LAS float* wexp = F + 256; LAS float* uu = F + 384; LAS float* cm = F + 512;
    const int lane = tid & 63, wave = __builtin_amdgcn_readfirstlane(tid >> 6), fr = lane & 15, fq = lane >> 4, row = 16 * wave + fr;
    for (int it = vcu; it < NB * NCH * NH; it += G) {
        const int h = it & 3, c = (it >> 2) & 63, b = it >> 8;
        const int t0 = b * SEQ + c * LCH; const int bhc = (b * NH + h) * NCH + c;
        __syncthreads();
        load_tile(T0, xcb + (size_t)t0 * 512 + h * 128, 512, tid);
        load_tile(T1, (const bf16*)(ws + WS_WQKV) + (0 * 4 + h) * 16384, 128, tid);
        if (tid < 128) { ipre[tid] = gates[(size_t)(t0 + tid) * 8 + h]; bcum[tid] = logsigmoid_f(gates[(size_t)(t0 + tid) * 8 + 4 + h]); }
        __syncthreads();
        if (wave == 0) {
            const float l0 = bcum[2 * lane], l1 = bcum[2 * lane + 1], i0 = ipre[2 * lane], i1 = ipre[2 * lane + 1];
            float sc = l0 + l1;
#pragma unroll
            for (int o = 1; o < 64; o <<= 1) { const float tt = __shfl_up(sc, o); if (lane >= o) sc += tt; }
            const float b0 = sc - l1, b1 = sc, g = __shfl(sc, 63);
            const float u0 = i0 - b0, u1 = i1 - b1;
            float mx = fmaxf(u0, u1);
#pragma unroll
            for (int o = 1; o < 64; o <<= 1) { const float tt = __shfl_up(mx, o); if (lane >= o) mx = fmaxf(mx, tt); }
            float pm = __shfl_up(mx, 1); if (lane == 0) pm = -3.0e38f;
            const float c0 = fmaxf(pm, u0), c1 = fmaxf(c0, u1);
            const float a0 = g - b0 + i0, a1 = g - b1 + i1, mls = wave_max(fmaxf(a0, a1));
            bcum[2 * lane] = b0; bcum[2 * lane + 1] = b1; uu[2 * lane] = u0; uu[2 * lane + 1] = u1; cm[2 * lane] = c0; cm[2 * lane + 1] = c1;
            wexp[2 * lane] = __expf(a0 - mls); wexp[2 * lane + 1] = __expf(a1 - mls);
            if (lane == 0) { ((float*)(ws + WS_GCH))[bhc] = g; ((float*)(ws + WS_MLS))[bhc] = mls; }
        }
        f32x4 acc[8], acc2[8];
        mm128(T0, T1, lane, wave, acc);
        store_tile_acc(T2, acc, row, fq);
#pragma unroll
        for (int n = 0; n < 8; ++n) { u32x2 w; w.x = pk2(acc[n].x, acc[n].y); w.y = pk2(acc[n].z, acc[n].w); *(u32x2*)(qb + (size_t)(t0 + row) * 512 + h * 128 + 16 * n + 4 * fq) = w; }
        __syncthreads();
        load_tile(T1, (const bf16*)(ws + WS_WQKV) + (1 * 4 + h) * 16384, 128, tid);
        __syncthreads();
        mm128(T0, T1, lane, wave, acc);
        store_tile_acc(T3, acc, row, fq);
        mm128(T1, T0, lane, wave, acc2);
        {
            float nl = 0.f;
#pragma unroll
            for (int n = 0; n < 8; ++n) { const int s0 = 16 * n + 4 * fq; nl += acc2[n].x * wexp[s0] + acc2[n].y * wexp[s0 + 1] + acc2[n].z * wexp[s0 + 2] + acc2[n].w * wexp[s0 + 3]; }
            nl += __shfl_xor(nl, 16); nl += __shfl_xor(nl, 32);
            if (fq == 0) ((float*)(ws + WS_NLOC))[(size_t)bhc * 128 + row] = nl;
        }
        __syncthreads();
        mm128(T2, T3, lane, wave, acc);
        float den = 0.f;
        {
            const float cmt = cm[row];
#pragma unroll
            for (int n = 0; n < 8; ++n) {
                const int s0 = 16 * n + 4 * fq;
                acc[n].x = (s0 <= row) ? rbf(__expf(uu[s0] - cmt) * acc[n].x) : 0.f;
                acc[n].y = (s0 + 1 <= row) ? rbf(__expf(uu[s0 + 1] - cmt) * acc[n].y) : 0.f;
                acc[n].z = (s0 + 2 <= row) ? rbf(__expf(uu[s0 + 2] - cmt) * acc[n].z) : 0.f;
                acc[n].w = (s0 + 3 <= row) ? rbf(__expf(uu[s0 + 3] - cmt) * acc[n].w) : 0.f;
                den += (acc[n].x + acc[n].y) + (acc[n].z + acc[n].w);
            }
            den += __shfl_xor(den, 16); den += __shfl_xor(den, 32);
        }
        load_tile(T0, proj + (size_t)t0 * 2048 + h * 128, 2048, tid);
        load_tile(T1, (const bf16*)(ws + WS_WQKV) + (2 * 4 + h) * 16384, 128, tid);
        __syncthreads();
        store_tile_acc(T2, acc, row, fq);
        store_tile_acc(T3, acc2, row, fq);
        mm128(T1, T0, lane, wave, acc);
        __syncthreads();
        store_tile_acc(T0, acc, row, fq);
#pragma unroll
        for (int n = 0; n < 8; ++n) { const int s0 = 16 * n + 4 * fq; acc[n].x *= wexp[s0]; acc[n].y *= wexp[s0 + 1]; acc[n].z *= wexp[s0 + 2]; acc[n].w *= wexp[s0 + 3]; }
        store_tile_acc(T1, acc, row, fq);
        __syncthreads();
        mm128(T2, T0, lane, wave, acc);
        {
            float* np = numl + (size_t)(t0 + row) * 512 + h * 128 + 4 * fq;
#pragma unroll
            for (int n = 0; n < 8; ++n) *(f32x4*)(np + 16 * n) = acc[n];
        }
        mm128(T1, T3, lane, wave, acc);
        {
            float* cp = cloc + (size_t)bhc * 16384 + row * 128 + 4 * fq;
#pragma unroll
            for (int n = 0; n < 8; ++n) *(f32x4*)(cp + 16 * n) = acc[n];
        }
        if (fq == 0) {
            ((float*)(ws + WS_BCUM))[(size_t)(t0 + row) * 4 + h] = bcum[row];
            ((float*)(ws + WS_MLOC))[(size_t)(t0 + row) * 4 + h] = bcum[row] + cm[row];
            ((float*)(ws + WS_DEN))[(size_t)(t0 + row) * 4 + h] = den;
        }
    }
}

__device__ __forceinline__ void phase_scan(const Args& a, int tid, int vcu, int G) {
    unsigned char* ws = a.ws;
    const float* gch = (const float*)(ws + WS_GCH); const float* mls = (const float*)(ws + WS_MLS);
    const float* cloc = (const float*)(ws + WS_CLOC); bf16* cprev = (bf16*)(ws + WS_CPREV);
    const float* nloc = (const float*)(ws + WS_NLOC); float* nprev = (float*)(ws + WS_NPREV); float* mprev = (float*)(ws + WS_MPREV);
    for (int it = vcu; it < 512 + 4; it += G) {
        if (it < 512) {
            const int bh = it >> 5, e = (it & 31) * 512 + tid;
            float m = 0.f, C = 0.f;
            for (int c = 0; c < NCH; ++c) {
                const size_t idx = (size_t)(bh * NCH + c) * 16384 + e;
                cprev[idx] = (bf16)f2bf(C);
                const float g = gch[bh * NCH + c], ml = mls[bh * NCH + c], mn = fmaxf(g + m, ml);
                C = __expf(g + m - mn) * C + __expf(ml - mn) * cloc[idx]; m = mn;
            }
        } else {
            const int gi = (it - 512) * 512 + tid, bh = gi >> 7, e = gi & 127;
            float m = 0.f, n = 0.f;
            for (int c = 0; c < NCH; ++c) {
                const size_t idx = (size_t)(bh * NCH + c) * 128 + e;
                nprev[idx] = n; if (e == 0) mprev[bh * NCH + c] = m;
                const float g = gch[bh * NCH + c], ml = mls[bh * NCH + c], mn = fmaxf(g + m, ml);
                n = __expf(g + m - mn) * n + __expf(ml - mn) * nloc[idx]; m = mn;
            }
        }
    }
}

__device__ __forceinline__ void phase_mixer_out(const Args& a, LAS unsigned char* lds, int tid, int vcu, int G) {
    unsigned char* ws = a.ws;
    const bf16* proj = (const bf16*)(ws + WS_PROJ); const bf16* xcb = (const bf16*)(ws + WS_XC); const bf16* qb = (const bf16*)(ws + WS_QB);
    const bf16* cprev = (const bf16*)(ws + WS_CPREV); const float* numl = (const float*)(ws + WS_NUML); bf16* mix = (bf16*)(ws + WS_MIX);
    LAS unsigned char* T0 = lds; LAS unsigned char* T1 = lds + 32768; LAS unsigned char* T2 = lds + 65536; LAS unsigned char* T3 = lds + 98304;
    const int lane = tid & 63, wave = __builtin_amdgcn_readfirstlane(tid >> 6), fr = lane & 15, fq = lane >> 4, row = 16 * wave + fr;
    for (int it = vcu; it < NB * NCH * NH; it += G) {
        const int h = it & 3, c = (it >> 2) & 63, b = it >> 8;
        const int t0 = b * SEQ + c * LCH; const int bhc = (b * NH + h) * NCH + c; const int tok = t0 + row;
        __syncthreads();
        load_tile(T0, qb + (size_t)t0 * 512 + h * 128, 512, tid);
        load_tile(T1, cprev + (size_t)bhc * 16384, 128, tid);
        load_tile(T2, (const bf16*)(ws + WS_WSP) + (size_t)h * 16384, 128, tid);
        {
            const int t = tid >> 2, j0 = (tid & 3) * 32;
            float vg[32]; float sm = 0.f;
#pragma unroll
            for (int i = 0; i < 32; i += 8) { float vf[8]; unpack8(*(const u32x4*)(proj + (size_t)(t0 + t) * 2048 + 1536 + h * 128 + j0 + i), vf);
#pragma unroll
                for (int e = 0; e < 8; ++e) { vg[i + e] = gelu_f(vf[e]); sm += vg[i + e]; } }
            sm += __shfl_xor(sm, 1); sm += __shfl_xor(sm, 2);
            const float mean = sm * (1.f / 128.f); float q = 0.f;
#pragma unroll
            for (int i = 0; i < 32; ++i) { vg[i] -= mean; q += vg[i] * vg[i]; }
            q += __shfl_xor(q, 1); q += __shfl_xor(q, 2);
            const float rstd = 1.f / sqrtf(q * (1.f / 128.f) + LN_EPS);
#pragma unroll
            for (int i = 0; i < 32; ++i) { const float v = vg[i] * rstd * a.in[14][h * 128 + j0 + i] + a.in[15][h * 128 + j0 + i];
                *(LAS unsigned short*)(T3 + toff<16>(j0 + i, t >> 3) + (t & 7) * 2) = (unsigned short)f2bf(v); }
        }
        __syncthreads();
        f32x4 acc[8];
        mm128(T0, T1, lane, wave, acc);
        {
            float nqi = 0.f;
            const float* np = (const float*)(ws + WS_NPREV) + (size_t)bhc * 128 + fq * 32;
#pragma unroll
            for (int cc = 0; cc < 4; ++cc) { float qf[8]; unpack8(ld_chunk<16>(T0, row, fq * 4 + cc), qf);
#pragma unroll
                for (int e = 0; e < 8; ++e) nqi = fmaf(qf[e], np[cc * 8 + e], nqi); }
            nqi += __shfl_xor(nqi, 16); nqi += __shfl_xor(nqi, 32);
            const float mp = ((const float*)(ws + WS_MPREV))[bhc];
            const float bc = ((const float*)(ws + WS_BCUM))[(size_t)tok * 4 + h], ml = ((const float*)(ws + WS_MLOC))[(size_t)tok * 4 + h], den = ((const float*)(ws + WS_DEN))[(size_t)tok * 4 + h];
            const float mt = fmaxf(bc + mp, ml), wi = __expf(bc + mp - mt), wl = __expf(ml - mt);
            const float nq = wi * nqi + wl * den, dn = 1.f / fmaxf(fabsf(nq), __expf(-mt));
            const float* nlp = numl + (size_t)tok * 512 + h * 128 + 4 * fq;
            float sm = 0.f;
#pragma unroll
            for (int n = 0; n < 8; ++n) { const f32x4 nl = *(const f32x4*)(nlp + 16 * n); acc[n] = (acc[n] * wi + nl * wl) * dn; sm += (acc[n].x + acc[n].y) + (acc[n].z + acc[n].w); }
            sm += __shfl_xor(sm, 16); sm += __shfl_xor(sm, 32);
            const float mean = sm * (1.f / 128.f); float q = 0.f;
#pragma unroll
            for (int n = 0; n < 8; ++n) { acc[n] = acc[n] - mean; q += (acc[n].x * acc[n].x + acc[n].y * acc[n].y) + (acc[n].z * acc[n].z + acc[n].w * acc[n].w); }
            q += __shfl_xor(q, 16); q += __shfl_xor(q, 32);
            const float rstd = 1.f / sqrtf(q * (1.f / 128.f) + LN_EPS);
#pragma unroll
            for (int n = 0; n < 8; ++n) {
                const int ch = h * 128 + 16 * n + 4 * fq;
                const u32x2 zr = *(const u32x2*)(proj + (size_t)tok * 2048 + 512 + ch), xr = *(const u32x2*)(xcb + (size_t)tok * 512 + ch);
                const f32x4 mg = *(const f32x4*)(a.in[12] + ch), sk = *(const f32x4*)(a.in[13] + ch);
                const float z0 = bf2f(zr.x & 0xffffu), z1 = bf2f(zr.x >> 16), z2 = bf2f(zr.y & 0xffffu), z3 = bf2f(zr.y >> 16);
                const float x0 = bf2f(xr.x & 0xffffu), x1 = bf2f(xr.x >> 16), x2 = bf2f(xr.y & 0xffffu), x3 = bf2f(xr.y >> 16);
                u32x2 w;
                w.x = pk2(sigmoid_f(z0) * (acc[n].x * rstd * mg.x + sk.x * x0), sigmoid_f(z1) * (acc[n].y * rstd * mg.y + sk.y * x1));
                w.y = pk2(sigmoid_f(z2) * (acc[n].z * rstd * mg.z + sk.z * x2), sigmoid_f(z3) * (acc[n].w * rstd * mg.w + sk.w * x3));
                *(u32x2*)(mix + (size_t)tok * 1024 + ch) = w;
            }
        }
        mm128(T2, T3, lane, wave, acc);
        {
            const float bsp = a.in[17][h * 128 + row];
#pragma unroll
            for (int n = 0; n < 8; ++n) {
                const int ch = h * 128 + 16 * n + 4 * fq;
                const u32x2 ur = *(const u32x2*)(proj + (size_t)tok * 2048 + 1024 + ch);
                const float u0 = gelu_f(bf2f(ur.x & 0xffffu)), u1 = gelu_f(bf2f(ur.x >> 16)), u2 = gelu_f(bf2f(ur.y & 0xffffu)), u3 = gelu_f(bf2f(ur.y >> 16));
                u32x2 w; w.x = pk2(u0 * (acc[n].x + bsp), u1 * (acc[n].y + bsp)); w.y = pk2(u2 * (acc[n].z + bsp), u3 * (acc[n].w + bsp));
                *(u32x2*)(mix + (size_t)tok * 1024 + 512 + ch) = w;
            }
        }
    }
}

__device__ __forceinline__ void phase_ln2(const Args& a, int lane, int gw, int NGW) {
    const float* mod = (const float*)(a.ws + WS_MOD); const bf16* mixo = (const bf16*)(a.ws + WS_MIXO); bf16* h2 = (bf16*)(a.ws + WS_H2);
    for (int row = gw; row < T; row += NGW) {
        const int b = row >> 13;
        const f32x4* xr = (const f32x4*)(a.in[0] + (size_t)row * D) + lane; const u32x2* mr = (const u32x2*)(mixo + (size_t)row * D) + lane;
        f32x4 v[4]; float s = 0.f;
#pragma unroll
        for (int j = 0; j < 4; ++j) { const int col = 4 * lane + 256 * j; const f32x4 x = xr[64 * j]; const u32x2 m = mr[64 * j];
            const f32x4 gt = *(const f32x4*)(mod + b * 6144 + 2048 + col);
            const f32x4 mv = {bf2f(m.x & 0xffffu), bf2f(m.x >> 16), bf2f(m.y & 0xffffu), bf2f(m.y >> 16)};
            v[j] = x * DN_ALPHA + (gt + 1.0f) * mv; s += (v[j].x + v[j].y) + (v[j].z + v[j].w); }
        float mean = wave_sum(s) * (1.f / D), s2 = 0.f;
#pragma unroll
        for (int j = 0; j < 4; ++j) { v[j] = v[j] - mean; s2 += (v[j].x * v[j].x + v[j].y * v[j].y) + (v[j].z * v[j].z + v[j].w * v[j].w); }
        float rstd = 1.f / sqrtf(wave_sum(s2) * (1.f / D) + LN_EPS);
        f32x4* xo = (f32x4*)(a.out + (size_t)row * D) + lane; s = 0.f;
#pragma unroll
        for (int j = 0; j < 4; ++j) { const int col = 4 * lane + 256 * j;
            v[j] = v[j] * rstd * *(const f32x4*)(a.in[19] + col) + *(const f32x4*)(a.in[20] + col); xo[64 * j] = v[j]; s += (v[j].x + v[j].y) + (v[j].z + v[j].w); }
        mean = wave_sum(s) * (1.f / D); s2 = 0.f;
#pragma unroll
        for (int j = 0; j < 4; ++j) { v[j] = v[j] - mean; s2 += (v[j].x * v[j].x + v[j].y * v[j].y) + (v[j].z * v[j].z + v[j].w * v[j].w); }
        rstd = 1.f / sqrtf(wave_sum(s2) * (1.f / D) + LN_EPS);
        u32x2* o8 = (u32x2*)(h2 + (size_t)row * D) + lane;
#pragma unroll
        for (int j = 0; j < 4; ++j) { const int col = 4 * lane + 256 * j;
            const f32x4 sh = *(const f32x4*)(mod + b * 6144 + 3072 + col), sc = *(const f32x4*)(mod + b * 6144 + 4096 + col);
            const f32x4 h = v[j] * rstd * (sc + 1.0f) + sh; u32x2 w; w.x = pk2(h.x, h.y); w.y = pk2(h.z, h.w); o8[64 * j] = w; }
    }
}

__device__ __forceinline__ void phase_route(const Args& a, int lane, int gw, int NGW) {
    unsigned char* ws = a.ws;
    const float* logits = (const float*)(ws + WS_LOG); const float* ebias = a.in[22];
    unsigned* cnt = (unsigned*)(ws + WS_CTL); int* topi = (int*)(ws + WS_TOPI); float* topw = (float*)(ws + WS_TOPW); int* list = (int*)(ws + WS_LIST);
    const f32x4 eb = *(const f32x4*)(ebias + lane * 4);
    for (int tok = gw; tok < T; tok += NGW) {
        const f32x4 lg = *(const f32x4*)(logits + (size_t)tok * 256 + lane * 4);
        float sc[4] = {sigmoid_f(lg.x), sigmoid_f(lg.y), sigmoid_f(lg.z), sigmoid_f(lg.w)};
        float sel[4] = {sc[0] + eb.x, sc[1] + eb.y, sc[2] + eb.z, sc[3] + eb.w};
        float m1 = fmaxf(sel[0], sel[1]), m2 = fminf(sel[0], sel[1]);
        { const float c = sel[2]; if (c > m1) { m2 = m1; m1 = c; } else if (c > m2) m2 = c; }
        { const float c = sel[3]; if (c > m1) { m2 = m1; m1 = c; } else if (c > m2) m2 = c; }
#pragma unroll
        for (int o = 1; o < 8; o <<= 1) { const float b1 = __shfl_xor(m1, o), b2 = __shfl_xor(m2, o); const float n1 = fmaxf(m1, b1), n2 = fmaxf(fminf(m1, b1), fmaxf(m2, b2)); m1 = n1; m2 = n2; }
        const float gs = m1 + m2; const int mygrp = lane >> 3; int rank = 0;
#pragma unroll
        for (int g = 0; g < 8; ++g) { const float og = __shfl(gs, g * 8); rank += (og > gs || (og == gs && g < mygrp)) ? 1 : 0; }
        const bool allowed = rank < 4;
#pragma unroll
        for (int i = 0; i < 4; ++i) if (!allowed) sel[i] = -INFINITY;
        int myE = 0; float myS = 0.f, ssum = 0.f;
#pragma unroll 1
        for (int k = 0; k < TOPK; ++k) {
            float bv = sel[0]; int bi = lane * 4;
            if (sel[1] > bv) { bv = sel[1]; bi = lane * 4 + 1; }
            if (sel[2] > bv) { bv = sel[2]; bi = lane * 4 + 2; }
            if (sel[3] > bv) { bv = sel[3]; bi = lane * 4 + 3; }
#pragma unroll
            for (int o = 1; o < 64; o <<= 1) { const float ov = __shfl_xor(bv, o); const int oi = __shfl_xor(bi, o); if (ov > bv || (ov == bv && oi < bi)) { bv = ov; bi = oi; } }
            const int sub = bi & 3; const float mysc = sub == 0 ? sc[0] : sub == 1 ? sc[1] : sub == 2 ? sc[2] : sc[3];
            const float wsc = __shfl(mysc, bi >> 2);
            if ((bi >> 2) == lane) { if (sub == 0) sel[0] = -INFINITY; else if (sub == 1) sel[1] = -INFINITY; else if (sub == 2) sel[2] = -INFINITY; else sel[3] = -INFINITY; }
            if (lane == k) { myE = bi; myS = wsc; }
            ssum += wsc;
        }
        if (lane < TOPK) {
            const float w = myS / ssum * ROUTE_SCALE;
            topi[(size_t)tok * 8 + lane] = myE; topw[(size_t)tok * 8 + lane] = w;
            const unsigned pos = atomicAdd(&cnt[myE], 1u);
            list[(size_t)myE * 32768 + pos] = tok * 8 + lane;
        }
    }
}

template <bool SHARED>
__device__ __forceinline__ void moe_item(const Args& a, LAS unsigned char* lds, LAS unsigned char* HT, const LAS int* sEnt, const LAS float* sW, const bf16* Wg, const bf16* Wu, const bf16* Wd, int tid, int lane, int wave) {
    unsigned char* ws = a.ws;
    const bf16* h2 = (const bf16*)(ws + WS_H2); bf16* Y = (bf16*)(ws + WS_Y); const float* mod = (const float*)(ws + WS_MOD);
    asm volatile("" : "+v"(tid)); lane = tid & 63;
    const int wm = wave >> 2, wn = wave & 3, fr = lane & 15, fq = lane >> 4;
#if USE_MFMA
    f32x4 acc[4][8];
    core_mfma<2, 4, 32, false, 4>(lds, nullptr,
        [&](int r) { int ent = sEnt[r]; if (ent < 0) ent = -1 - ent; const int tokr = SHARED ? ent : (ent >> 3); return h2 + (size_t)tokr * 1024; },
        [&](int r) { const int wq = r >> 7, x = r & 127; return (x < 64) ? Wg + (size_t)(wq * 64 + x) * 1024 : Wu + (size_t)(wq * 64 + x - 64) * 1024; }, 1024, acc, tid, lane, wave);
#pragma unroll
    for (int m = 0; m < 4; ++m)
#pragma unroll
        for (int n = 0; n < 4; ++n) { const f32x4 g = acc[m][n], u = acc[m][n + 4];
            st_elem4<32>(HT, wm * 64 + 16 * m + fr, wn * 64 + 16 * n + 4 * fq, silu_f(g.x) * u.x, silu_f(g.y) * u.y, silu_f(g.z) * u.z, silu_f(g.w) * u.w); }
    __syncthreads();
#pragma unroll 1
    for (int nh = 0; nh < 2; ++nh) {
        const bf16* Wdb = Wd + (size_t)(nh * 512) * 256;
        core_mfma<2, 4, 32, true, 32>(lds, HT, [&](int r) { return (const bf16*)nullptr; }, [&](int r) { return Wdb + (size_t)r * 256; }, 256, acc, tid, lane, wave);
#pragma unroll
        for (int m = 0; m < 4; ++m) {
            const int row = wm * 64 + 16 * m + fr; const int ent = sEnt[row];
            if (SHARED) {
                const int b = ent >> 13; float* xp = a.out + (size_t)ent * 1024 + nh * 512 + wn * 128 + 4 * fq; const float* gp = mod + b * 6144 + 5120 + nh * 512 + wn * 128 + 4 * fq;
#pragma unroll
                for (int n = 0; n < 8; ++n) { const f32x4 x1 = *(const f32x4*)(xp + 16 * n), gt = *(const f32x4*)(gp + 16 * n);
                    *(f32x4*)(xp + 16 * n) = x1 * DN_ALPHA + (gt + 1.0f) * acc[m][n]; if (n & 1) asm volatile("" ::: "memory"); }
            } else if (ent >= 0) {
                const float w = sW[row]; bf16* yp = Y + (size_t)ent * 1024 + nh * 512 + wn * 128 + 4 * fq;
#pragma unroll
                for (int n = 0; n < 8; ++n) { const f32x4 v = acc[m][n] * w; u32x2 o; o.x = pk2(v.x, v.y); o.y = pk2(v.z, v.w); *(u32x2*)(yp + 16 * n) = o; }
            }
        }
    }
#else
    {
        const bf16* arow[4];
#pragma unroll
        for (int m = 0; m < 4; ++m) { int ent = sEnt[wm * 64 + 16 * m + fr]; if (ent < 0) ent = -1 - ent; const int tokr = SHARED ? ent : (ent >> 3); arow[m] = h2 + (size_t)tokr * 1024; }
        const bf16* Wgb = Wg + (size_t)(wn * 64 + 4 * fq) * 1024; const bf16* Wub = Wu + (size_t)(wn * 64 + 4 * fq) * 1024;
#pragma unroll 1
        for (int nq = 0; nq < 4; ++nq) {
            f32x4 acc[4][2];
            core_naive<2>([&](int m, int k8) { return *(const u32x4*)(arow[m] + 8 * k8); },
                          [&](int n, int r, int k8) { const bf16* base = (n == 0) ? Wgb : Wub; return *(const u32x4*)(base + (size_t)(16 * nq + r) * 1024 + 8 * k8); }, 1024, acc);
#pragma unroll
            for (int m = 0; m < 4; ++m) { const f32x4 g = acc[m][0], u = acc[m][1];
                st_elem4<32>(HT, wm * 64 + 16 * m + fr, wn * 64 + 16 * nq + 4 * fq, silu_f(g.x) * u.x, silu_f(g.y) * u.y, silu_f(g.z) * u.z, silu_f(g.w) * u.w); }
        }
    }
    __syncthreads();
#pragma unroll 1
    for (int nh = 0; nh < 8; ++nh) {
        f32x4 acc[4][2];
        const bf16* Wdb = Wd + (size_t)(nh * 128 + wn * 32 + 4 * fq) * 256;
        core_naive<2>([&](int m, int k8) { return ld_chunk<32>(HT, wm * 64 + 16 * m + fr, k8); },
                      [&](int n, int r, int k8) { return *(const u32x4*)(Wdb + (size_t)(16 * n + r) * 256 + 8 * k8); }, 256, acc);
#pragma unroll
        for (int m = 0; m < 4; ++m) {
            const int row = wm * 64 + 16 * m + fr; const int ent = sEnt[row];
            if (SHARED) {
                const int b = ent >> 13; float* xp = a.out + (size_t)ent * 1024 + nh * 128 + wn * 32 + 4 * fq; const float* gp = mod + b * 6144 + 5120 + nh * 128 + wn * 32 + 4 * fq;
#pragma unroll
                for (int n = 0; n < 2; ++n) { const f32x4 x1 = *(const f32x4*)(xp + 16 * n), gt = *(const f32x4*)(gp + 16 * n);
                    *(f32x4*)(xp + 16 * n) = x1 * DN_ALPHA + (gt + 1.0f) * acc[m][n]; }
            } else if (ent >= 0) {
                const float w = sW[row]; bf16* yp = Y + (size_t)ent * 1024 + nh * 128 + wn * 32 + 4 * fq;
#pragma unroll
                for (int n = 0; n < 2; ++n) { const f32x4 v = acc[m][n] * w; u32x2 o; o.x = pk2(v.x, v.y); o.y = pk2(v.z, v.w); *(u32x2*)(yp + 16 * n) = o; }
            }
        }
    }
#endif
}
__device__ __forceinline__ void phase_moe(const Args& a, LAS unsigned char* lds, int tid, int lane, int wave, int vcu, int G) {
    unsigned char* ws = a.ws;
    const unsigned* cnt = (const unsigned*)(ws + WS_CTL); const int* list = (const int*)(ws + WS_LIST); const float* topw = (const float*)(ws + WS_TOPW);
    LAS unsigned char* HT = lds + 81920;
    LAS int* pre = (LAS int*)(lds + 147456);
    LAS int* sEnt = (LAS int*)(lds + 147456 + 2048);
    LAS float* sW = (LAS float*)(lds + 147456 + 2048 + 512);
    if (tid == 0) { int s = 0; for (int e = 0; e < NE; ++e) { pre[e] = s; s += (int)((cnt[e] + 127u) >> 7); } pre[NE] = s; }
    __syncthreads();
    const int nrouted = pre[NE], nitems = nrouted + T / 128;
    for (int rep = 0; rep < REPK(11); ++rep)
    for (int it = vcu; it < (rep == 0 ? nitems : nrouted); it += G) {
        __syncthreads();
        if (it >= nrouted) {
            if (tid < 128) { sEnt[tid] = (it - nrouted) * 128 + tid; sW[tid] = 1.f; }
            __syncthreads();
            moe_item<true>(a, lds, HT, sEnt, sW, (const bf16*)(ws + WS_WSG), (const bf16*)(ws + WS_WSU), (const bf16*)(ws + WS_WSD), tid, lane, wave);
        } else {
            int lo = 0, hi = NE - 1; while (lo < hi) { const int mid = (lo + hi + 1) >> 1; if (pre[mid] <= it) lo = mid; else hi = mid - 1; }
            const int e = lo, rb = it - pre[e];
            if (tid < 128) { const int n_e = (int)cnt[e], li = rb * 128 + tid; const bool valid = li < n_e; const int ent = list[(size_t)e * 32768 + (valid ? li : rb * 128)];
                sEnt[tid] = valid ? ent : -1 - ent; sW[tid] = valid ? topw[ent] : 0.f; }
            __syncthreads();
            moe_item<false>(a, lds, HT, sEnt, sW, (const bf16*)(ws + WS_WEG) + (size_t)e * 262144, (const bf16*)(ws + WS_WEU) + (size_t)e * 262144, (const bf16*)(ws + WS_WED) + (size_t)e * 262144, tid, lane, wave);
        }
    }
}

__device__ __forceinline__ void phase_final(const Args& a, int lane, int gw, int NGW) {
    const float* mod = (const float*)(a.ws + WS_MOD); const bf16* Y = (const bf16*)(a.ws + WS_Y);
    for (int row = gw; row < T; row += NGW) {
        const int b = row >> 13;
        f32x4* xr = (f32x4*)(a.out + (size_t)row * D) + lane;
        f32x4 v[4]; float s = 0.f;
#pragma unroll
        for (int j = 0; j < 4; ++j) { const int col = 4 * lane + 256 * j; f32x4 r = {0.f, 0.f, 0.f, 0.f};
#pragma unroll
            for (int k = 0; k < TOPK; ++k) { const u32x2 m = *((const u32x2*)(Y + ((size_t)row * 8 + k) * 1024) + lane + 64 * j);
                r += (f32x4){bf2f(m.x & 0xffffu), bf2f(m.x >> 16), bf2f(m.y & 0xffffu), bf2f(m.y >> 16)}; }
            const f32x4 gt = *(const f32x4*)(mod + b * 6144 + 5120 + col);
            v[j] = xr[64 * j] + (gt + 1.0f) * r; s += (v[j].x + v[j].y) + (v[j].z + v[j].w); }
        const float mean = wave_sum(s) * (1.f / D); float s2 = 0.f;
#pragma unroll
        for (int j = 0; j < 4; ++j) { v[j] = v[j] - mean; s2 += (v[j].x * v[j].x + v[j].y * v[j].y) + (v[j].z * v[j].z + v[j].w * v[j].w); }
        const float rstd = 1.f / sqrtf(wave_sum(s2) * (1.f / D) + LN_EPS);
#pragma unroll
        for (int j = 0; j < 4; ++j) { const int col = 4 * lane + 256 * j; xr[64 * j] = v[j] * rstd * *(const f32x4*)(a.in[29] + col) + *(const f32x4*)(a.in[30] + col); }
    }
}

#define XB_TMO      128
#define XB_XCNT(j)  (256  + 64 * (j))
#define XB_XSUB(j)  (1280 + 64 * (j))
#define XB_XGEN(j)  (2304 + 64 * (j))
#define XB_TOP      3328
#define XB_TOPGEN   3392
#define XCD_BAR_WORDS 3456
#define XB_SPIN_CAP (1u << 20)
constexpr int CW_BAR = 4096;
__device__ __forceinline__ unsigned xb_ld(unsigned* p)              { return __hip_atomic_load(p, __ATOMIC_RELAXED, __HIP_MEMORY_SCOPE_AGENT); }
__device__ __forceinline__ unsigned xb_add(unsigned* p, unsigned v) { return __hip_atomic_fetch_add(p, v, __ATOMIC_RELAXED, __HIP_MEMORY_SCOPE_AGENT); }
__device__ __forceinline__ unsigned xb_xcc_id() { return (unsigned)__builtin_amdgcn_s_getreg((3 << 11) | 20) & 0xFu; }
#define XB_SPIN(cond, bar) do { unsigned _sp = 0; while (cond) { __builtin_amdgcn_s_sleep(1); \
    if ((++_sp & 255u) == 0u) { if (xb_ld(&(bar)[XB_TMO])) break; if (_sp > XB_SPIN_CAP) { atomicAdd(&(bar)[XB_TMO], 1u); break; } } } } while (0)
struct XcdBarrier { unsigned* bar; unsigned x; volatile LAS unsigned* st; };
__device__ __forceinline__ XcdBarrier xcd_barrier_post(unsigned* bar, volatile LAS unsigned* st) {
    XcdBarrier b; b.bar = bar; b.x = xb_xcc_id(); b.st = st;
    if (threadIdx.x == 0) (void)xb_add(&bar[XB_XCNT(b.x)], 1u);
    return b;
}
__device__ __forceinline__ void xcd_barrier_complete(unsigned* bar, unsigned x, unsigned& nloc, unsigned& nx) {
    const unsigned G = gridDim.x * gridDim.y * gridDim.z;
    unsigned sum, cnt, mine, sp = 0u;
    for (;;) {
        sum = 0u; cnt = 0u; mine = 0u;
#pragma unroll
        for (unsigned j = 0; j < 16; ++j) { const unsigned c = xb_ld(&bar[XB_XCNT(j)]); sum += c; cnt += (c > 0u) ? 1u : 0u; mine = (j == x) ? c : mine; }
        if (sum == G) break;
        __builtin_amdgcn_s_sleep(1);
        if ((++sp & 255u) == 0u) { if (xb_ld(&bar[XB_TMO])) break; if (sp > XB_SPIN_CAP) { atomicAdd(&bar[XB_TMO], 1u); break; } }
    }
    nloc = mine > 0u ? mine : 1u; nx = cnt > 0u ? cnt : 1u;
}
__device__ __forceinline__ void xcd_barrier(const XcdBarrier& b) {
    asm volatile("s_waitcnt vmcnt(0)" ::: "memory");
    __syncthreads();
    if (threadIdx.x == 0) {
        unsigned* bar = b.bar;
        __builtin_amdgcn_s_waitcnt(0);
        unsigned nloc = b.st[0], nx = b.st[1];
        if (nloc == 0u) { xcd_barrier_complete(bar, b.x, nloc, nx); b.st[0] = nloc; b.st[1] = nx; }
        const unsigned old = xb_add(&bar[XB_XSUB(b.x)], 1u);
        const unsigned gen = old / nloc;
        if (old + 1u == (gen + 1u) * nloc) {
            __builtin_amdgcn_fence(__ATOMIC_RELEASE, "agent");
            asm volatile("s_waitcnt vmcnt(0)" ::: "memory");
            const unsigned og = xb_add(&bar[XB_TOP], 1u);
            const unsigned tg = og / nx;
            if (og + 1u == (tg + 1u) * nx) xb_add(&bar[XB_TOPGEN], 1u);
            else XB_SPIN(xb_ld(&bar[XB_TOPGEN]) == tg, bar);
            __builtin_amdgcn_fence(__ATOMIC_ACQUIRE, "agent");
            xb_add(&bar[XB_XGEN(b.x)], 1u);
            asm volatile("s_waitcnt vmcnt(0)" ::: "memory");
        } else {
            XB_SPIN(xb_ld(&bar[XB_XGEN(b.x)]) == gen, bar);
            __builtin_amdgcn_fence(__ATOMIC_ACQUIRE, "agent");
            asm volatile("s_waitcnt vmcnt(0)" ::: "memory");
        }
    }
    __syncthreads();
}

constexpr int LDS_BAR_OFF = LDS_BYTES - 64;
__global__ void __launch_bounds__(NTHREADS, 2) mk_fwd(Args a) {
    extern __shared__ __attribute__((aligned(16))) unsigned char lds_raw[];
    LAS unsigned char* lds = (LAS unsigned char*)lds_raw;
    const int tid = threadIdx.x, lane = tid & 63, wave = __builtin_amdgcn_readfirstlane(tid >> 6);
    const int G = gridDim.x, bx = blockIdx.x, vcu = (G % 8 == 0) ? (bx % 8) * (G / 8) + bx / 8 : bx;
    const int gw = vcu * NWAVES + wave, NGW = G * NWAVES;
    unsigned char* ws = a.ws;
    if (tid < 16) ((LAS unsigned*)(lds + LDS_BAR_OFF))[tid] = 0u;
    __syncthreads();
    const XcdBarrier bar = xcd_barrier_post((unsigned*)(ws + WS_CTL) + CW_BAR, (volatile LAS unsigned*)(lds + LDS_BAR_OFF));
    const int lo = a.ph_lo, hi = a.ph_hi;
#define IN(k) (lo <= (k) && (k) < hi && PHEN(k))
#define SEAM(k) do { if (IN(k) && IN((k) + 1)) xcd_barrier(bar); } while (0)
    if (IN(0)) for (int rep = 0; rep < REPK(0); ++rep) phase_prep(a, lds, tid, lane, wave, vcu, G);
    SEAM(0);
    if (IN(1)) phase_ln1(a, lane, gw, NGW);
    SEAM(1);
    if (IN(2)) for (int rep = 0; rep < REPK(2); ++rep) { bf16* proj = (bf16*)(ws + WS_PROJ);
        phase_gemm_dense((const bf16*)(ws + WS_HB), (const bf16*)(ws + WS_WIN), T, 2048, 1024, lds, tid, lane, wave, vcu, G,
            [&](int row, int col, f32x4 v) { u32x2 o; o.x = pk2(v.x, v.y); o.y = pk2(v.z, v.w); *(u32x2*)(proj + (size_t)row * 2048 + col) = o; }); }
    SEAM(2);
    if (IN(3)) phase_conv_gates(a, lane, gw, NGW);
    SEAM(3);
    if (IN(4)) for (int rep = 0; rep < REPK(4); ++rep) phase_mlstm_local(a, lds, tid, vcu, G);
    SEAM(4);
    if (IN(5)) phase_scan(a, tid, vcu, G);
    SEAM(5);
    if (IN(6)) for (int rep = 0; rep < REPK(6); ++rep) phase_mixer_out(a, lds, tid, vcu, G);
    SEAM(6);
    if (IN(7)) for (int rep = 0; rep < REPK(7); ++rep) { bf16* mixo = (bf16*)(ws + WS_MIXO);
        phase_gemm_dense((const bf16*)(ws + WS_MIX), (const bf16*)(ws + WS_WOUT), T, 1024, 1024, lds, tid, lane, wave, vcu, G,
            [&](int row, int col, f32x4 v) { u32x2 o; o.x = pk2(v.x, v.y); o.y = pk2(v.z, v.w); *(u32x2*)(mixo + (size_t)row * 1024 + col) = o; }); }
    SEAM(7);
    if (IN(8)) phase_ln2(a, lane, gw, NGW);
    SEAM(8);
    if (IN(9)) for (int rep = 0; rep < REPK(9); ++rep) { float* lg = (float*)(ws + WS_LOG);
        phase_gemm_dense((const bf16*)(ws + WS_H2), (const bf16*)(ws + WS_WR), T, 256, 1024, lds, tid, lane, wave, vcu, G,
            [&](int row, int col, f32x4 v) { *(f32x4*)(lg + (size_t)row * 256 + col) = v; }); }
    SEAM(9);
    if (IN(10)) phase_route(a, lane, gw, NGW);
    SEAM(10);
    if (IN(11)) phase_moe(a, lds, tid, lane, wave, vcu, G);
    SEAM(11);
    if (IN(12)) phase_final(a, lane, gw, NGW);
#undef IN
#undef SEAM
}

extern "C" void kernel_launch(void* const* d_in, const int* in_sizes, int n_in, void* d_out, int out_size, void* d_ws, size_t ws_size, hipStream_t stream) {
    static int grid = 0;
    if (grid == 0) {
        if (n_in != 31 || out_size != T * D || ws_size < WS_END) { fprintf(stderr, "kernel_launch: unexpected problem (n_in %d out %d ws %zu)\n", n_in, out_size, ws_size); grid = -1; return; }
        int dev = 0, cus = 0, per_cu = 0;
        if (hipGetDevice(&dev) != hipSuccess || hipDeviceGetAttribute(&cus, hipDeviceAttributeMultiprocessorCount, dev) != hipSuccess) { grid = -1; return; }
        if (hipFuncSetAttribute((const void*)mk_fwd, hipFuncAttributeMaxDynamicSharedMemorySize, LDS_BYTES) != hipSuccess) { fprintf(stderr, "kernel_launch: hipFuncSetAttribute failed\n"); grid = -1; return; }
        if (hipOccupancyMaxActiveBlocksPerMultiprocessor(&per_cu, (const void*)mk_fwd, NTHREADS, LDS_BYTES) != hipSuccess || per_cu < 1) fprintf(stderr, "kernel_launch: occupancy query reports %d\n", per_cu);
        (void)hipGetLastError();
        grid = cus;
    }
    if (grid < 0) return;
    (void)hipMemsetAsync((char*)d_ws + WS_CTL, 0, CTL_BYTES, stream);
    Args a{};
    for (int i = 0; i < 31; ++i) a.in[i] = (const float*)d_in[i];
    a.out = (float*)d_out; a.ws = (unsigned char*)d_ws; a.ph_lo = 0; a.ph_hi = NPHASE;
    hipLaunchKernelGGL(mk_fwd, dim3(grid), dim3(NTHREADS), LDS_BYTES, stream, a);
}
```
